# Optimizing an MI355X kernel written in HIP

```python
import math
import jax, jax.numpy as jnp
from jax import lax
import numpy as np

D_MODEL = 2048
BATCH = 1
SEQ = 16384
DEPTH = 1

ATTN_WIDTH = D_MODEL // 2
SSM_WIDTH = D_MODEL - ATTN_WIDTH
HEAD_DIM = 128
N_HEADS = ATTN_WIDTH // HEAD_DIM
ROT_DIM = HEAD_DIM // 4
ROPE_THETA = 500000.0
DILATED_PATTERNS = ((128, 1), (512, 4), (2048, 16))
ATT_BLOCK = 128
SSM_GROUP = 16
N_SSM_GROUPS = SSM_WIDTH // SSM_GROUP
SSM_STATE = 64
DT_MIN = 1e-3
DT_MAX = 1e-1
D_FF = -(-8 * D_MODEL // (3 * 256)) * 256
IN_WIDTH = 3 * ATTN_WIDTH + SSM_WIDTH
RMS_EPS = 1e-6

kernel_name = "hymba_dilated_attn_s5_hybrid"


def _rmsnorm(t, g):
    tf = t.astype(jnp.float32)
    tf = tf * lax.rsqrt(jnp.mean(tf * tf, axis=-1, keepdims=True) + RMS_EPS)
    return (tf * g.astype(jnp.float32)).astype(t.dtype)


def _rotary_tables(seq):
    pos = jnp.arange(seq, dtype=jnp.float32)
    inv_freq = ROPE_THETA ** (-jnp.arange(0, ROT_DIM, 2, dtype=jnp.float32) / ROT_DIM)
    ang = pos[:, None] * inv_freq[None, :]
    return jnp.cos(ang)[None, :, None, :], jnp.sin(ang)[None, :, None, :]


def _apply_partial_rope(t, cos, sin):
    rot, rest = t[..., :ROT_DIM], t[..., ROT_DIM:]
    x1, x2 = rot[..., :ROT_DIM // 2], rot[..., ROT_DIM // 2:]
    return jnp.concatenate([x1 * cos - x2 * sin, x2 * cos + x1 * sin, rest], axis=-1)


def _dilated_band_attention(q, k, v, dilation, band):
    b, s, h, hd = q.shape
    L = s // dilation
    nb = -(-L // ATT_BLOCK)
    pad = nb * ATT_BLOCK - L

    def to_lattice(t):
        return t.reshape(b, L, dilation, h, hd)

    ql = jnp.pad(to_lattice(q), ((0, 0), (0, pad), (0, 0), (0, 0), (0, 0)))
    kl = jnp.pad(to_lattice(k), ((0, 0), (ATT_BLOCK, pad), (0, 0), (0, 0), (0, 0)))
    vl = jnp.pad(to_lattice(v), ((0, 0), (ATT_BLOCK, pad), (0, 0), (0, 0), (0, 0)))
    qb = ql.reshape(b, nb, ATT_BLOCK, dilation, h, hd)
    kb = kl.reshape(b, nb + 1, ATT_BLOCK, dilation, h, hd)
    vb = vl.reshape(b, nb + 1, ATT_BLOCK, dilation, h, hd)
    kw = jnp.concatenate([kb[:, :-1], kb[:, 1:]], axis=2)
    vw = jnp.concatenate([vb[:, :-1], vb[:, 1:]], axis=2)

    scores = jnp.einsum('bnqrhd,bnkrhd->bnrhqk', qb, kw)
    qi = jnp.arange(ATT_BLOCK)[:, None]
    kj = jnp.arange(2 * ATT_BLOCK)[None, :]
    dist = qi - kj + ATT_BLOCK
    key_idx = jnp.arange(nb)[:, None, None] * ATT_BLOCK + kj[None] - ATT_BLOCK
    valid = (dist >= 0) & (dist <= band) & (key_idx >= 0)
    scores = jnp.where(valid[None, :, None, None], scores, -jnp.inf)
    m = jnp.max(scores, axis=-1)
    p = jnp.exp(scores - m[..., None])
    l = jnp.sum(p, axis=-1)
    o = jnp.einsum('bnrhqk,bnkrhd->bnqrhd', p, vw)

    def from_lattice(t):
        tail = t.shape[5:]
        t = t.reshape((b, nb * ATT_BLOCK, dilation, h) + tail)[:, :L]
        return t.reshape((b, s, h) + tail)

    m = jnp.moveaxis(m, -1, 2)
    l = jnp.moveaxis(l, -1, 2)
    return from_lattice(o), from_lattice(m), from_lattice(l)


def _dilated_attention_mixer(q, k, v, cos, sin):
    b, s, _ = q.shape
    split = lambda t: t.astype(jnp.float32).reshape(b, s, N_HEADS, HEAD_DIM)
    qh = _apply_partial_rope(split(q), cos, sin) * (HEAD_DIM ** -0.5)
    kh = _apply_partial_rope(split(k), cos, sin)
    vh = split(v)
    parts = [_dilated_band_attention(qh, kh, vh, dil, win // dil) for win, dil in DILATED_PATTERNS]
    m_all = jnp.max(jnp.stack([m for _, m, _ in parts], axis=0), axis=0)
    num = 0.0
    den = 0.0
    for o_i, m_i, l_i in parts:
        w_i = jnp.exp(m_i - m_all)
        num = num + w_i[..., None] * o_i
        den = den + w_i * l_i
    out = num / den[..., None]
    return out.reshape(b, s, ATTN_WIDTH).astype(q.dtype)


def _s5_mixer(u, a_re, a_im, log_dt, b_re, b_im, c_re, c_im, d_skip, w_glu, b_glu):
    bsz, s, _ = u.shape
    f32 = jnp.float32
    uf = u.astype(f32).reshape(bsz, s, N_SSM_GROUPS, SSM_GROUP)
    lam = lax.complex(a_re.astype(f32), a_im.astype(f32))
    dt = jnp.exp(log_dt.astype(f32))[:, None]
    a_bar = jnp.exp(lam * dt)
    b_mat = lax.complex(b_re.astype(f32), b_im.astype(f32))
    b_bar = ((a_bar - 1.0) / lam)[..., None] * b_mat
    bu = jnp.einsum('bsgp,gnp->bsgn', uf.astype(jnp.complex64), b_bar)
    a_seq = jnp.broadcast_to(a_bar, bu.shape)

    def combine(e1, e2):
        a1, x1 = e1
        a2, x2 = e2
        return a1 * a2, a2 * x1 + x2

    _, states = lax.associative_scan(combine, (a_seq, bu), axis=1)
    c_mat = lax.complex(c_re.astype(f32), c_im.astype(f32))
    y = jnp.einsum('bsgn,gpn->bsgp', states, c_mat).real + d_skip.astype(f32) * uf
    y = jax.nn.gelu(y.reshape(bsz, s, SSM_WIDTH))
    gate = jax.nn.sigmoid(y @ w_glu.astype(f32) + b_glu.astype(f32))
    return (y * gate).astype(u.dtype)


def setup_inputs(seed: int = 0) -> dict:
    key = jax.random.key(seed)
    ks = jax.random.split(key, 20)
    f32 = jnp.float32
    nrm = lambda k, shape, scale: jax.random.normal(k, shape, f32) * scale
    x = jax.random.normal(ks[0], (BATCH, SEQ, D_MODEL), f32)
    norm1_g = 1.0 + nrm(ks[1], (DEPTH, D_MODEL), 0.02)
    w_in = nrm(ks[2], (DEPTH, D_MODEL, IN_WIDTH), D_MODEL ** -0.5)
    a_re = -0.5 + nrm(ks[3], (DEPTH, N_SSM_GROUPS, SSM_STATE), 0.01)
    a_im = (math.pi * jnp.arange(SSM_STATE, dtype=f32))[None, None, :] + nrm(ks[4], (DEPTH, N_SSM_GROUPS, SSM_STATE), 0.01)
    log_dt = jax.random.uniform(ks[5], (DEPTH, N_SSM_GROUPS), f32, math.log(DT_MIN), math.log(DT_MAX))
    b_re = nrm(ks[6], (DEPTH, N_SSM_GROUPS, SSM_STATE, SSM_GROUP), (2 * SSM_GROUP) ** -0.5)
    b_im = nrm(ks[7], (DEPTH, N_SSM_GROUPS, SSM_STATE, SSM_GROUP), (2 * SSM_GROUP) ** -0.5)
    c_re = nrm(ks[8], (DEPTH, N_SSM_GROUPS, SSM_GROUP, SSM_STATE), (2 * SSM_STATE) ** -0.5)
    c_im = nrm(ks[9], (DEPTH, N_SSM_GROUPS, SSM_GROUP, SSM_STATE), (2 * SSM_STATE) ** -0.5)
    d_skip = nrm(ks[10], (DEPTH, N_SSM_GROUPS, SSM_GROUP), 1.0)
    w_glu = nrm(ks[11], (DEPTH, SSM_WIDTH, SSM_WIDTH), SSM_WIDTH ** -0.5)
    b_glu = nrm(ks[12], (DEPTH, SSM_WIDTH), 0.02)
    w_out = nrm(ks[13], (DEPTH, ATTN_WIDTH + SSM_WIDTH, D_MODEL), (ATTN_WIDTH + SSM_WIDTH) ** -0.5)
    norm2_g = 1.0 + nrm(ks[14], (DEPTH, D_MODEL), 0.02)
    w_gate = nrm(ks[15], (DEPTH, D_MODEL, D_FF), D_MODEL ** -0.5)
    w_up = nrm(ks[16], (DEPTH, D_MODEL, D_FF), D_MODEL ** -0.5)
    w_down = nrm(ks[17], (DEPTH, D_FF, D_MODEL), D_FF ** -0.5)
    final_g = 1.0 + nrm(ks[18], (D_MODEL,), 0.02)
    return {"x": x, "norm1_g": norm1_g, "w_in": w_in, "a_re": a_re, "a_im": a_im,
            "log_dt": log_dt, "b_re": b_re, "b_im": b_im, "c_re": c_re, "c_im": c_im,
            "d_skip": d_skip, "w_glu": w_glu, "b_glu": b_glu, "w_out": w_out,
            "norm2_g": norm2_g, "w_gate": w_gate, "w_up": w_up, "w_down": w_down,
            "final_g": final_g}


def reference(x, norm1_g, w_in, a_re, a_im, log_dt, b_re, b_im, c_re, c_im, d_skip,
              w_glu, b_glu, w_out, norm2_g, w_gate, w_up, w_down, final_g):
    _, s, _ = x.shape
    cos, sin = _rotary_tables(s)
    h = x
    for layer in range(DEPTH):
        hn = _rmsnorm(h, norm1_g[layer])
        proj = hn @ w_in[layer]
        q, k, v, u = jnp.split(proj, [ATTN_WIDTH, 2 * ATTN_WIDTH, 3 * ATTN_WIDTH], axis=-1)
        attn_out = _dilated_attention_mixer(q, k, v, cos, sin)
        ssm_out = _s5_mixer(u, a_re[layer], a_im[layer], log_dt[layer], b_re[layer],
                            b_im[layer], c_re[layer], c_im[layer], d_skip[layer],
                            w_glu[layer], b_glu[layer])
        h = h + jnp.concatenate([attn_out, ssm_out], axis=-1) @ w_out[layer]
        hn = _rmsnorm(h, norm2_g[layer])
        h = h + (jax.nn.silu(hn @ w_gate[layer]) * (hn @ w_up[layer])) @ w_down[layer]
    return _rmsnorm(h, final_g)
```

```cpp
#include <hip/hip_runtime.h>
#include <hip/hip_cooperative_groups.h>
#include <cstdio>
#include <cstdint>
#include <cmath>
namespace cg = cooperative_groups;
#define N_LAUNCH_MODE 0
#define USE_PG8 1
#define NAIVE_S5 0
#define NAIVE_ATTN 0
namespace pg8 {
#define PG8_LAS __attribute__((address_space(3)))
typedef unsigned short bf16_t;
typedef short bf16x8 __attribute__((ext_vector_type(8)));
typedef float f32x4 __attribute__((ext_vector_type(4)));
typedef unsigned u32x4 __attribute__((ext_vector_type(4)));
constexpr int BM = 256, BK = 64, HALF = 128, HTB = HALF * BK * 2  , STAGE_BYTES = 8 * HTB, NXCD = 8, WGM = 8;

__host__ __device__ __forceinline__ int lds_byte(int r, int c) { const int st = (r >> 4) * 2 + (c >> 5), rr = r & 15, cc = c & 31, ob = rr * 64 + cc * 2; return st * 1024 + (ob ^ (((ob >> 9) & 1) << 5)); }
__host__ __device__ __forceinline__ void stage_rc(int b, int& R, int& C) { const int st = b / 1024, sb = b % 1024, swz = sb ^ (((sb >> 9) & 1) << 5); R = (st >> 1) * 16 + swz / 64; C = (st & 1) * 32 + (swz % 64) / 2; }
__host__ __device__ __forceinline__ int perm32(int rho) { const int n = rho >> 4, i = rho & 15; return 8 * (i >> 2) + 4 * n + (i & 3); }

struct Unit { int pm, pn; };
struct Gemm { const bf16_t* A; const bf16_t* Bt; int M, N, K; };

struct StaticOrder {
    int nM, nN, nwg, G, c;
    __host__ __device__ void init(int M, int N, int G_, int c_) { nM = M / BM; nN = N / BM; nwg = nM * nN; G = G_; c = c_; }
    __host__ __device__ bool next(int i, Unit& u) const {
        const long L = (long)i * G + c; if (L >= nwg) return false;
        int wgid = (int)L; { const int q = nwg / NXCD, r = nwg % NXCD, xcd = wgid % NXCD, off = wgid / NXCD; wgid = (xcd < r ? xcd * (q + 1) : r * (q + 1) + (xcd - r) * q) + off; }
        const int nig = WGM * nN, gid = wgid / nig, fm = gid * WGM, gsz = (nM - fm) < WGM ? (nM - fm) : WGM;
        u.pm = fm + ((wgid % nig) % gsz); u.pn = (wgid % nig) / gsz; return true;
    }
    __device__ __forceinline__ void a_ready(const Unit&) const {}
    __device__ __forceinline__ void done(const Unit&) const {}
};

__device__ __forceinline__ unsigned cvt_pk_bf16(float lo, float hi) { unsigned r; asm volatile("v_cvt_pk_bf16_f32 %0, %1, %2" : "=v"(r) : "v"(lo), "v"(hi)); return r; }
template <class Epi, class Sched, bool ALIGN_EPI = false, bool SP2 = false>
__device__ __forceinline__ void gemm_phase(PG8_LAS unsigned char* lds, const Gemm g, const Sched& S, const Epi& E) {
    const int tid = threadIdx.x, wid = __builtin_amdgcn_readfirstlane(tid >> 6), lane = tid & 63, wr = wid >> 2, wc = wid & 3, fr = lane & 15, fq = lane >> 4;
    const int K = g.K, nt = K / BK;
    unsigned voffA[2], voffB[2];
#pragma unroll
    for (int i = 0; i < 2; ++i) { int R, C; stage_rc(tid * 16 + i * 8192, R, C); const int Rb = Epi::PERM ? ((R & ~31) + perm32(R & 31)) : R;
        voffA[i] = (unsigned)(R * K + C) * 2u; voffB[i] = (unsigned)(Rb * K + C) * 2u; }
    const size_t kstep = (size_t)(BK * 2);
    const size_t hstep = (size_t)HALF * K * 2;
    const size_t tstep = 2 * hstep;
    const unsigned ldsw = (unsigned)wid * 1024u;
    const int aoff = lds_byte(wr * 64 + fr, fq * 8), boff = lds_byte(wc * 32 + fr, fq * 8);
#define PG8_SA(b, h) (((b) * 2 + (h)) * HTB)
#define PG8_SB(b, h) ((4 + (b) * 2 + (h)) * HTB)
#define PG8_STAGE(bufoff, gbase, voff) do { _Pragma("unroll") for (int _i = 0; _i < 2; ++_i) \
        __builtin_amdgcn_global_load_lds((const unsigned*)((const char*)(gbase) + (voff)[_i]), (PG8_LAS unsigned*)(lds + (bufoff) + ldsw + _i * 8192), 16, 0, 0); } while (0)
#define PG8_LDA(dst, b, h) do { _Pragma("unroll") for (int m = 0; m < 4; ++m) _Pragma("unroll") for (int k = 0; k < 2; ++k) dst[m][k] = *(const PG8_LAS bf16x8*)(lds + PG8_SA(b, h) + aoff + m * 2048 + k * 1024); } while (0)
#define PG8_LDB(dst, b, h) do { _Pragma("unroll") for (int n = 0; n < 2; ++n) _Pragma("unroll") for (int k = 0; k < 2; ++k) dst[n][k] = *(const PG8_LAS bf16x8*)(lds + PG8_SB(b, h) + boff + n * 2048 + k * 1024); } while (0)
#define PG8_MMA(ai, bj, At, Bt) do { __builtin_amdgcn_s_setprio(1); _Pragma("unroll") for (int m = 0; m < 4; ++m) _Pragma("unroll") for (int n = 0; n < 2; ++n) _Pragma("unroll") for (int k = 0; k < 2; ++k) \
        acc[ai][bj][m][n] = __builtin_amdgcn_mfma_f32_16x16x32_bf16(Bt[n][k], At[m][k], acc[ai][bj][m][n], 0, 0, 0); __builtin_amdgcn_s_setprio(0); } while (0)
#define PG8_WAIT_V(n) asm volatile("s_waitcnt vmcnt(" #n ")" ::: "memory")
#define PG8_WAIT_L(n) asm volatile("s_waitcnt lgkmcnt(" #n ")" ::: "memory")
#define PG8_BAR __builtin_amdgcn_s_barrier()
#define PG8_SCHED __builtin_amdgcn_sched_barrier(0)
    Unit cur, nxt; int ui = 0;
    if (!S.next(0, cur)) return;
    f32x4 acc[2][2][4][2];
#pragma unroll
    for (int a = 0; a < 2; ++a)
#pragma unroll
        for (int b = 0; b < 2; ++b)
#pragma unroll
            for (int m = 0; m < 4; ++m)
#pragma unroll
                for (int n = 0; n < 2; ++n) acc[a][b][m][n] = (f32x4){0.f, 0.f, 0.f, 0.f};
    bf16x8 At[4][2], B0[2][2], B1[2][2];
    const char* cA = (const char*)g.A + (size_t)cur.pm * tstep; const char* cB = (const char*)g.Bt + (size_t)cur.pn * tstep;
    S.a_ready(cur);
    if constexpr (SP2) {
        PG8_STAGE(PG8_SB(0, 0), cB, voffB); PG8_STAGE(PG8_SB(0, 1), cB + hstep, voffB); PG8_STAGE(PG8_SA(0, 0), cA, voffA); PG8_STAGE(PG8_SA(0, 1), cA + hstep, voffA);
        if (wr == 1) PG8_BAR;
        PG8_WAIT_V(2); PG8_BAR;
        PG8_STAGE(PG8_SB(1, 0), cB + kstep, voffB); PG8_STAGE(PG8_SA(1, 0), cA + kstep, voffA); PG8_STAGE(PG8_SB(1, 1), cB + hstep + kstep, voffB);
        PG8_WAIT_V(6); PG8_BAR;
    } else {
        PG8_STAGE(PG8_SB(0, 0), cB, voffB); PG8_STAGE(PG8_SA(0, 0), cA, voffA); PG8_STAGE(PG8_SB(0, 1), cB + hstep, voffB); PG8_STAGE(PG8_SA(0, 1), cA + hstep, voffA);
        if (wr == 1) PG8_BAR;
        PG8_WAIT_V(4); PG8_BAR;
        PG8_STAGE(PG8_SB(1, 0), cB + kstep, voffB); PG8_STAGE(PG8_SA(1, 0), cA + kstep, voffA); PG8_STAGE(PG8_SB(1, 1), cB + hstep + kstep, voffB);
        PG8_WAIT_V(6); PG8_BAR;
    }
    for (;;) {
        const bool has_next = S.next(ui + 1, nxt);
        const char* nA = has_next ? (const char*)g.A + (size_t)nxt.pm * tstep : cA; const char* nB = has_next ? (const char*)g.Bt + (size_t)nxt.pn * tstep : cB;
        for (int t = 0; t < nt; t += 2) {
            const bool last = (t == nt - 2);
            const char* a1 = cA + (size_t)(t + 1) * kstep;
            const char* a2 = last ? nA : cA + (size_t)(t + 2) * kstep; const char* b2 = last ? nB : cB + (size_t)(t + 2) * kstep;
            const char* a3 = a2 + kstep; const char* b3 = b2 + kstep;
            if (last && has_next) S.a_ready(nxt);
            if constexpr (SP2) {
            PG8_LDB(B0, 0, 0); PG8_LDB(B1, 0, 1); PG8_SCHED; PG8_LDA(At, 0, 0); PG8_STAGE(PG8_SA(1, 1), a1 + hstep, voffA);
            PG8_WAIT_V(8); PG8_WAIT_L(0); PG8_BAR; PG8_MMA(0, 0, At, B0); PG8_MMA(0, 1, At, B1); PG8_BAR; PG8_SCHED;
            PG8_LDA(At, 0, 1); PG8_STAGE(PG8_SB(0, 0), b2, voffB); PG8_STAGE(PG8_SB(0, 1), b2 + hstep, voffB); PG8_STAGE(PG8_SA(0, 0), a2, voffA);
            PG8_WAIT_V(8); PG8_WAIT_L(0); PG8_BAR; PG8_MMA(1, 0, At, B0); PG8_MMA(1, 1, At, B1); PG8_BAR; PG8_SCHED;
            PG8_LDB(B0, 1, 0); PG8_LDB(B1, 1, 1); PG8_SCHED; PG8_LDA(At, 1, 0); PG8_STAGE(PG8_SA(0, 1), a2 + hstep, voffA);
            PG8_WAIT_V(8); PG8_WAIT_L(0); PG8_BAR; PG8_MMA(0, 0, At, B0); PG8_MMA(0, 1, At, B1); PG8_BAR; PG8_SCHED;
            PG8_LDA(At, 1, 1); PG8_STAGE(PG8_SB(1, 0), b3, voffB); PG8_STAGE(PG8_SB(1, 1), b3 + hstep, voffB); PG8_STAGE(PG8_SA(1, 0), a3, voffA);
            PG8_WAIT_V(8); PG8_WAIT_L(0); PG8_BAR; PG8_MMA(1, 0, At, B0); PG8_MMA(1, 1, At, B1); PG8_BAR; PG8_SCHED;
            } else {
            PG8_LDB(B0, 0, 0); PG8_SCHED; PG8_LDA(At, 0, 0); PG8_STAGE(PG8_SA(1, 1), a1 + hstep, voffA);
            PG8_WAIT_L(8); PG8_BAR; PG8_WAIT_L(0); PG8_MMA(0, 0, At, B0); PG8_BAR; PG8_SCHED;
            PG8_LDB(B1, 0, 1); PG8_STAGE(PG8_SB(0, 0), b2, voffB);
            PG8_BAR; PG8_WAIT_L(0); PG8_MMA(0, 1, At, B1); PG8_BAR;
            PG8_LDA(At, 0, 1); PG8_STAGE(PG8_SA(0, 0), a2, voffA);
            PG8_BAR; PG8_WAIT_L(0); PG8_MMA(1, 0, At, B0); PG8_BAR; PG8_SCHED;
            PG8_STAGE(PG8_SB(0, 1), b2 + hstep, voffB);
            PG8_WAIT_V(6); PG8_BAR; PG8_MMA(1, 1, At, B1); PG8_BAR;
            PG8_LDB(B0, 1, 0); PG8_SCHED; PG8_LDA(At, 1, 0); PG8_STAGE(PG8_SA(0, 1), a2 + hstep, voffA);
            PG8_WAIT_L(8); PG8_BAR; PG8_WAIT_L(0); PG8_MMA(0, 0, At, B0); PG8_BAR; PG8_SCHED;
            PG8_LDB(B1, 1, 1); PG8_STAGE(PG8_SB(1, 0), b3, voffB);
            PG8_BAR; PG8_WAIT_L(0); PG8_MMA(0, 1, At, B1); PG8_BAR;
            PG8_LDA(At, 1, 1); PG8_STAGE(PG8_SA(1, 0), a3, voffA);
            PG8_BAR; PG8_WAIT_L(0); PG8_MMA(1, 0, At, B0); PG8_BAR; PG8_SCHED;
            PG8_STAGE(PG8_SB(1, 1), b3 + hstep, voffB);
            PG8_WAIT_V(6); PG8_BAR; PG8_MMA(1, 1, At, B1); PG8_BAR;
            }
        }
        if constexpr (ALIGN_EPI) { if (wr == 0) PG8_BAR; }
        if constexpr (!Epi::AFTER_DRAIN) { E(acc, cur, wr, wc, fr, fq); S.done(cur); }
        if (!has_next) break;
#pragma unroll
        for (int a = 0; a < 2; ++a)
#pragma unroll
            for (int b = 0; b < 2; ++b)
#pragma unroll
                for (int m = 0; m < 4; ++m)
#pragma unroll
                    for (int n = 0; n < 2; ++n) acc[a][b][m][n] = (f32x4){0.f, 0.f, 0.f, 0.f};
        cur = nxt; cA = nA; cB = nB; ++ui;
        if constexpr (ALIGN_EPI) { if (wr == 1) PG8_BAR; }
    }
    PG8_WAIT_V(0);
    if constexpr (!ALIGN_EPI) { if (wr == 0) PG8_BAR; }
    PG8_BAR;
    if constexpr (Epi::AFTER_DRAIN) { E.fused(acc, cur, wr, wc, fr, fq, lds, wid, lane); S.done(cur); }
#undef PG8_SA
#undef PG8_SB
#undef PG8_STAGE
#undef PG8_LDA
#undef PG8_LDB
#undef PG8_MMA
#undef PG8_WAIT_V
#undef PG8_WAIT_L
#undef PG8_BAR
#undef PG8_SCHED
}
}

struct Args { const float* in[19]; float* out; unsigned char* ws; int ph_lo, ph_hi; };

#define LAS __attribute__((address_space(3)))
typedef unsigned short bf16;
typedef short bf16x8 __attribute__((ext_vector_type(8)));
typedef float f32x4 __attribute__((ext_vector_type(4)));
typedef float f32x16 __attribute__((ext_vector_type(16)));
typedef unsigned u32x4 __attribute__((ext_vector_type(4)));
typedef unsigned u32x2 __attribute__((ext_vector_type(2)));

#ifndef N_LAUNCH_MODE
#define N_LAUNCH_MODE 0
#endif
#ifndef USE_PG8
#define USE_PG8 1
#endif
#ifndef NAIVE_ATTN
#define NAIVE_ATTN 1
#endif
#ifndef NAIVE_S5
#define NAIVE_S5 1
#endif

constexpr int S = 16384, DM = 2048, AW = 1024, HD = 128, NH = 8, DFF = 5632, INW = 4096;
constexpr int NG = 64;
constexpr float EPS = 1e-6f;
constexpr float QSCALE = 0.08838834764831845f * 1.4426950408889634f;
#ifndef H1_BF16
#define H1_BF16 1
#endif
#ifndef FUSE_NORM
#define FUSE_NORM 1
#endif
constexpr int NPHASE = FUSE_NORM ? 9 : 10;

constexpr size_t MiB = 1u << 20;
constexpr size_t WS_SS2 = 0, WS_SS3 = 65536, WS_R1 = 131072, WS_ROPEC = 1 * MiB, WS_ROPES = 2 * MiB;
constexpr size_t WS_WIN = 16 * MiB, WS_WGLU = 32 * MiB, WS_WOUT = 34 * MiB, WS_WGU = 42 * MiB, WS_WDN = 86 * MiB;
constexpr size_t WS_XB = 108 * MiB;
constexpr size_t WS_Q = 172 * MiB, WS_K = 204 * MiB, WS_V = 236 * MiB, WS_U = 268 * MiB, WS_Y = 300 * MiB, WS_CAT = 332 * MiB;
constexpr size_t WS_HH = 172 * MiB;
constexpr size_t WS_END = 396 * MiB;
constexpr int LDS_BYTES = 147456 + 64, LDS_CTL = 147456;
constexpr size_t WS_BAR = 8 * MiB;

__device__ __forceinline__ unsigned f2bf(float f) { unsigned u = __builtin_bit_cast(unsigned, f); return (u + 0x7fffu + ((u >> 16) & 1u)) >> 16; }
typedef float f32x2_t __attribute__((ext_vector_type(2))); typedef __bf16 bf16x2_t __attribute__((ext_vector_type(2)));
__device__ __forceinline__ unsigned pk2(float lo, float hi) { f32x2_t v = {lo, hi}; bf16x2_t b = __builtin_convertvector(v, bf16x2_t); return __builtin_bit_cast(unsigned, b); }
__device__ __forceinline__ float bflo(unsigned w) { return __uint_as_float(w << 16); }
__device__ __forceinline__ float bfhi(unsigned w) { return __uint_as_float(w & 0xffff0000u); }
__device__ __forceinline__ float bf2f(bf16 b) { return __uint_as_float((unsigned)b << 16); }
__device__ __forceinline__ float wave_sum(float v) {
#pragma unroll
    for (int o = 1; o < 64; o <<= 1) v += __shfl_xor(v, o);
    return v;
}
__device__ __forceinline__ float wave_max(float v) {
#pragma unroll
    for (int o = 1; o < 64; o <<= 1) v = fmaxf(v, __shfl_xor(v, o));
    return v;
}
#define WSYNC() do { asm volatile("s_waitcnt lgkmcnt(0)" ::: "memory"); __builtin_amdgcn_wave_barrier(); } while (0)

__device__ __forceinline__ float gelu_tanh(float x) {
    const float t = 0.7978845608028654f * (x + 0.044715f * x * x * x);
    const float e = __expf(2.f * t);
    const float th = 1.f - 2.f * __builtin_amdgcn_rcpf(e + 1.f);
    return 0.5f * x * (1.f + th);
}
__device__ __forceinline__ float sigmoidf_(float z) { return __builtin_amdgcn_rcpf(1.f + __expf(-z)); }

__device__ __forceinline__ int rowmap(int mode, int n) {
    if (mode == 1) {
        if (n < 2048 && (n & 127) < 32) { const int d = n & 31; const int c = (d < 16) ? (8 * (d >> 2) + (d & 3)) : (8 * ((d - 16) >> 2) + 4 + (d & 3)); return (n & ~31) + c; }
        return n;
    }
    if (mode == 2 || mode == 3) { const int q = n >> 2, ch = (q & ~3) + (((q & 1) << 1) | ((q >> 1) & 1)); return 8 * ch + (mode == 3 ? 4 : 0) + (n & 3); }
    return n;
}
__device__ __forceinline__ void conv_item(const float* __restrict__ W, int K, int N, bf16* WT, const float* __restrict__ g, int mode, LAS float* scr, int item, int lane) {
    const int nblk = N / 64, kb = item / nblk, nb = item % nblk, k0 = 64 * kb, n0 = 64 * nb;
    f32x4 v[16];
#pragma unroll
    for (int i = 0; i < 16; ++i) v[i] = __builtin_nontemporal_load((const f32x4*)(W + (size_t)(k0 + 4 * i + (lane >> 4)) * N + n0 + 4 * (lane & 15)));
#pragma unroll
    for (int i = 0; i < 16; ++i) { const int kk = 4 * i + (lane >> 4); const float sc = g ? g[k0 + kk] : 1.f; LAS float* d = scr + kk * 65 + 4 * (lane & 15);
        d[0] = v[i][0] * sc; d[1] = v[i][1] * sc; d[2] = v[i][2] * sc; d[3] = v[i][3] * sc; }
    WSYNC();
    const int c = lane & 7;
#pragma unroll
    for (int j = 0; j < 8; ++j) { const int n = (lane >> 3) + 8 * j; const LAS float* s = scr + (8 * c) * 65 + n;
        u32x4 o; o.x = pk2(s[0 * 65], s[1 * 65]); o.y = pk2(s[2 * 65], s[3 * 65]); o.z = pk2(s[4 * 65], s[5 * 65]); o.w = pk2(s[6 * 65], s[7 * 65]);
        *(u32x4*)(WT + (size_t)rowmap(mode, n0 + n) * K + k0 + 8 * c) = o; }
    WSYNC();
}

struct F1 {
    static constexpr bool HAS_SS = false;
    struct Pre { float r; f32x4 cs, sn; };
    const float* r1; const float* rc; const float* rs; bf16 *Q, *K, *V, *U; float* ss;
    __device__ __forceinline__ void load(int row, int col, Pre& p) const {
        p.r = r1[row];
        const int reg = col >> 10, c = col & 1023;
        if (reg < 2 && (c & 127) < 32) { const int a = (c & 31) >> 3; p.cs = *(const f32x4*)(rc + (size_t)row * 16 + 4 * a); p.sn = *(const f32x4*)(rs + (size_t)row * 16 + 4 * a); }
    }
    __device__ __forceinline__ float apply(int row, int col, float (&v)[8], const Pre& p) const {
        const float r = p.r;
#pragma unroll
        for (int i = 0; i < 8; ++i) v[i] *= r;
        const int reg = col >> 10, c = col & 1023;
        bf16* dst;
        if (reg < 2) {
            if ((c & 127) < 32) {
#pragma unroll
                for (int i = 0; i < 4; ++i) { const float x1 = v[i], x2 = v[4 + i]; v[i] = x1 * p.cs[i] - x2 * p.sn[i]; v[4 + i] = x2 * p.cs[i] + x1 * p.sn[i]; }
            }
            if (reg == 0) {
#pragma unroll
                for (int i = 0; i < 8; ++i) v[i] *= QSCALE;
            }
            dst = (reg == 0 ? Q : K) + (size_t)row * 1024 + c;
        } else if (reg == 2) dst = V + (size_t)row * 1024 + c;
        else dst = U + ((size_t)(c >> 4) * S + row) * 16 + (c & 15);
        u32x4 o; o.x = pk2(v[0], v[1]); o.y = pk2(v[2], v[3]); o.z = pk2(v[4], v[5]); o.w = pk2(v[6], v[7]);
        *(u32x4*)dst = o;
        return 0.f;
    }
};
struct F2 {
    static constexpr bool HAS_SS = false;
    struct Pre { u32x4 yw; f32x4 b0, b1; };
    const bf16* Y; const float* b; bf16* CAT; float* ss;
    __device__ __forceinline__ void load(int row, int col, Pre& p) const { p.yw = *(const u32x4*)(Y + (size_t)row * 1024 + col); p.b0 = *(const f32x4*)(b + col); p.b1 = *(const f32x4*)(b + col + 4); }
    __device__ __forceinline__ float apply(int row, int col, float (&v)[8], const Pre& p) const {
        const u32x4 yw = p.yw;
        float y[8] = {bflo(yw.x), bfhi(yw.x), bflo(yw.y), bfhi(yw.y), bflo(yw.z), bfhi(yw.z), bflo(yw.w), bfhi(yw.w)};
        float o[8];
#pragma unroll
        for (int i = 0; i < 8; ++i) { const float z = v[i] + (i < 4 ? p.b0[i] : p.b1[i - 4]); o[i] = y[i] * sigmoidf_(z); }
        u32x4 w; w.x = pk2(o[0], o[1]); w.y = pk2(o[2], o[3]); w.z = pk2(o[4], o[5]); w.w = pk2(o[6], o[7]);
        *(u32x4*)(CAT + (size_t)row * 2048 + 1024 + col) = w;
        return 0.f;
    }
};
struct F3 {
    static constexpr bool HAS_SS = true;
    struct Pre { f32x4 x0, x1; };
    const float* x; float* H1; bf16* HB; float* ss;
#ifndef XRES_BF16
#define XRES_BF16 1
#endif
    __device__ __forceinline__ void load(int row, int col, Pre& p) const { const size_t off = (size_t)row * 2048 + col;
#if XRES_BF16
        const u32x4 w = *(const u32x4*)(HB + off);
        p.x0 = (f32x4){bflo(w.x), bfhi(w.x), bflo(w.y), bfhi(w.y)}; p.x1 = (f32x4){bflo(w.z), bfhi(w.z), bflo(w.w), bfhi(w.w)};
#else
        p.x0 = __builtin_nontemporal_load((const f32x4*)(x + off)); p.x1 = __builtin_nontemporal_load((const f32x4*)(x + off + 4));
#endif
    }
    __device__ __forceinline__ float apply(int row, int col, float (&v)[8], const Pre& p) const {
        const size_t off = (size_t)row * 2048 + col;
        f32x4 h0, h1; float s = 0.f;
#pragma unroll
        for (int i = 0; i < 4; ++i) { h0[i] = p.x0[i] + v[i]; h1[i] = p.x1[i] + v[4 + i]; s += h0[i] * h0[i] + h1[i] * h1[i]; }
#if !H1_BF16
        *(f32x4*)(H1 + off) = h0; *(f32x4*)(H1 + off + 4) = h1;
#endif
        u32x4 w; w.x = pk2(h0[0], h0[1]); w.y = pk2(h0[2], h0[3]); w.z = pk2(h1[0], h1[1]); w.w = pk2(h1[2], h1[3]);
        *(u32x4*)(HB + off) = w;
        return s;
    }
};
struct F4 {
    static constexpr bool HAS_SS = false;
    struct Pre { float s; };
    const float* ss2; bf16* HH; float* ss;
    __device__ __forceinline__ void load(int row, int col, Pre& p) const { p.s = ss2[row]; }
    __device__ __forceinline__ float apply(int row, int col, float (&v)[8], const Pre& p) const {
        const float r = rsqrtf(p.s * (1.f / 2048.f) + EPS);
        float o[4];
#pragma unroll
        for (int i = 0; i < 4; ++i) { const float g = v[i] * r, u = v[4 + i] * r; o[i] = g * sigmoidf_(g) * u; }
        u32x2 w; w.x = pk2(o[0], o[1]); w.y = pk2(o[2], o[3]);
        { const int ch = col >> 3, hc = 4 * ((ch & ~3) + (((ch & 1) << 1) | ((ch >> 1) & 1))); *(u32x2*)(HH + (size_t)row * DFF + hc) = w; }
        return 0.f;
    }
};
struct F5 {
    static constexpr bool HAS_SS = true;
    struct Pre { f32x4 h0, h1; };
    float* H; float* ss;
    __device__ __forceinline__ void load(int row, int col, Pre& p) const { const size_t off = (size_t)row * 2048 + col; p.h0 = *(const f32x4*)(H + off); p.h1 = *(const f32x4*)(H + off + 4); }
    __device__ __forceinline__ float apply(int row, int col, float (&v)[8], const Pre& p) const {
        const size_t off = (size_t)row * 2048 + col;
        f32x4 h0 = p.h0, h1 = p.h1; float s = 0.f;
#pragma unroll
        for (int i = 0; i < 4; ++i) { h0[i] += v[i]; h1[i] += v[4 + i]; s += h0[i] * h0[i] + h1[i] * h1[i]; }
        *(f32x4*)(H + off) = h0; *(f32x4*)(H + off + 4) = h1;
        return s;
    }
};

struct F0 {
    static constexpr bool HAS_SS = false;
    struct Pre { float s; };
    float* sink; float* ss;
    __device__ __forceinline__ void load(int, int, Pre& p) const { p.s = 0.f; }
    __device__ __forceinline__ float apply(int row, int col, float (&v)[8], const Pre&) const {
        const float t = (v[0] + v[1]) + (v[2] + v[3]) + (v[4] + v[5]) + (v[6] + v[7]);
        if (t == 1234567.125f) sink[0] = t;
        return 0.f;
    }
};

template <class F> struct EpiChunk {
    static constexpr bool PERM = true, AFTER_DRAIN = false;
    F f;
    __device__ __forceinline__ void operator()(const pg8::f32x4 (&acc)[2][2][4][2], const pg8::Unit& u, int wr, int wc, int fr, int fq) const {
        const int row0 = u.pm * 256 + wr * 64 + fr, col0 = u.pn * 256 + wc * 32 + 8 * fq;
        typename F::Pre pa[2], pb[2];
        f.load(row0, col0, pa[0]); f.load(row0, col0 + 128, pa[1]);
#pragma unroll
        for (int g = 0; g < 8; ++g) {
            const int ai = g >> 2, m = g & 3, row = row0 + ai * 128 + m * 16;
            if (g < 7) { const int row2 = row0 + ((g + 1) >> 2) * 128 + ((g + 1) & 3) * 16;
                if (g & 1) { f.load(row2, col0, pa[0]); f.load(row2, col0 + 128, pa[1]); } else { f.load(row2, col0, pb[0]); f.load(row2, col0 + 128, pb[1]); } }
            float ss = 0.f;
#pragma unroll
            for (int bj = 0; bj < 2; ++bj) {
                float v[8] = {acc[ai][bj][m][0][0], acc[ai][bj][m][0][1], acc[ai][bj][m][0][2], acc[ai][bj][m][0][3], acc[ai][bj][m][1][0], acc[ai][bj][m][1][1], acc[ai][bj][m][1][2], acc[ai][bj][m][1][3]};
                ss += f.apply(row, col0 + bj * 128, v, (g & 1) ? pb[bj] : pa[bj]);
            }
            if (F::HAS_SS) { ss += __shfl_xor(ss, 16); ss += __shfl_xor(ss, 32); if (fq == 0) atomicAdd(f.ss + row, ss); }
        }
    }
};

struct EpiSwiGLU {
    static constexpr bool PERM = true, AFTER_DRAIN = false;
    const float* ss2; bf16* HH;
    __device__ __forceinline__ void operator()(const pg8::f32x4 (&acc)[2][2][4][2], const pg8::Unit& u, int wr, int wc, int fr, int fq) const {
        const int row0 = u.pm * 256 + wr * 64 + fr, col0 = u.pn * 256 + wc * 32 + 8 * fq;
        float rs[8];
#pragma unroll
        for (int g = 0; g < 8; ++g) rs[g] = ss2[row0 + (g >> 2) * 128 + (g & 3) * 16];
#pragma unroll
        for (int g = 0; g < 8; ++g) rs[g] = rsqrtf(rs[g] * (1.f / 2048.f) + EPS);
        const int sg = ((fq & 1) << 1) | (fq >> 1);
        const bool up = fq >= 2;
#pragma unroll
        for (int ai = 0; ai < 2; ++ai)
#pragma unroll
            for (int mp = 0; mp < 2; ++mp) {
                const int rowA = row0 + ai * 128 + (2 * mp) * 16, rowB = rowA + 16;
                const float rA = rs[ai * 4 + 2 * mp], rB = rs[ai * 4 + 2 * mp + 1];
#pragma unroll
                for (int bj = 0; bj < 2; ++bj) {
                    const int ch = (col0 + bj * 128) >> 3, hc = 4 * ((ch & ~3) + sg);
                    float oa[4], ob[4];
#pragma unroll
                    for (int i = 0; i < 4; ++i) {
                        const float ga = acc[ai][bj][2 * mp][0][i] * rA, ua = acc[ai][bj][2 * mp][1][i] * rA; oa[i] = ga * sigmoidf_(ga) * ua;
                        const float gb = acc[ai][bj][2 * mp + 1][0][i] * rB, ub = acc[ai][bj][2 * mp + 1][1][i] * rB; ob[i] = gb * sigmoidf_(gb) * ub;
                    }
                    unsigned ax = pk2(oa[0], oa[1]), ay = pk2(oa[2], oa[3]), bx = pk2(ob[0], ob[1]), by = pk2(ob[2], ob[3]);
                    { auto rx = __builtin_amdgcn_permlane32_swap(ax, bx, false, false); ax = rx[0]; bx = rx[1]; }
                    { auto ry = __builtin_amdgcn_permlane32_swap(ay, by, false, false); ay = ry[0]; by = ry[1]; }
                    u32x4 o = {ax, ay, bx, by};
                    *(u32x4*)(HH + (size_t)(up ? rowB : rowA) * DFF + (up ? hc - 4 : hc)) = o;
                }
            }
    }
};

constexpr size_t WS_CNT = 9 * MiB;
struct PanelOrder : pg8::StaticOrder {
    __device__ __forceinline__ bool next(int i, pg8::Unit& u) const { const long L = (long)i * G + c; if (L >= nwg) return false; const int xcd = (int)(L & 7), off = (int)(L >> 3); u.pm = xcd * 8 + (off >> 3); u.pn = off & 7; return true; }
};
struct EpiDownNorm {
    static constexpr bool PERM = true, AFTER_DRAIN = false;
    const float* H1; const bf16* HB; float* out; float* ss; unsigned* cnt; const float* fg;
    __device__ __forceinline__ void operator()(const pg8::f32x4 (&acc)[2][2][4][2], const pg8::Unit& u, int wr, int wc, int fr, int fq) const {
        const int row0 = u.pm * 256 + wr * 64 + fr, col0 = u.pn * 256 + wc * 32 + 8 * fq;
        f32x4 h[2][2][4][2];
#pragma unroll
        for (int ai = 0; ai < 2; ++ai)
#pragma unroll
            for (int bj = 0; bj < 2; ++bj)
#pragma unroll
                for (int m = 0; m < 4; ++m) { h[ai][bj][m][0] = acc[ai][bj][m][0]; h[ai][bj][m][1] = acc[ai][bj][m][1]; }
        f32x4 pa[2][2], pb[2][2];
#if H1_BF16
#define EDN_LOAD(P, row) do { const bf16* s_ = HB + (size_t)(row) * 2048 + col0; const u32x4 w0_ = *(const u32x4*)s_, w1_ = *(const u32x4*)(s_ + 128); \
        P[0][0] = (f32x4){bflo(w0_.x), bfhi(w0_.x), bflo(w0_.y), bfhi(w0_.y)}; P[0][1] = (f32x4){bflo(w0_.z), bfhi(w0_.z), bflo(w0_.w), bfhi(w0_.w)}; \
        P[1][0] = (f32x4){bflo(w1_.x), bfhi(w1_.x), bflo(w1_.y), bfhi(w1_.y)}; P[1][1] = (f32x4){bflo(w1_.z), bfhi(w1_.z), bflo(w1_.w), bfhi(w1_.w)}; } while (0)
#else
#define EDN_LOAD(P, row) do { const float* s_ = H1 + (size_t)(row) * 2048 + col0; P[0][0] = *(const f32x4*)s_; P[0][1] = *(const f32x4*)(s_ + 4); P[1][0] = *(const f32x4*)(s_ + 128); P[1][1] = *(const f32x4*)(s_ + 132); } while (0)
#endif
        EDN_LOAD(pa, row0);
#pragma unroll
        for (int g = 0; g < 8; ++g) {
            const int ai = g >> 2, m = g & 3, row = row0 + ai * 128 + m * 16;
            if (g < 7) { const int row2 = row0 + ((g + 1) >> 2) * 128 + ((g + 1) & 3) * 16; if (g & 1) EDN_LOAD(pa, row2); else EDN_LOAD(pb, row2); }
            float s = 0.f;
#pragma unroll
            for (int bj = 0; bj < 2; ++bj)
#pragma unroll
                for (int n = 0; n < 2; ++n) { const f32x4 hv = h[ai][bj][m][n] + ((g & 1) ? pb[bj][n] : pa[bj][n]); h[ai][bj][m][n] = hv; s += (hv[0] * hv[0] + hv[1] * hv[1]) + (hv[2] * hv[2] + hv[3] * hv[3]); }
            s += __shfl_xor(s, 16); s += __shfl_xor(s, 32);
            if (fq == 0) atomicAdd(ss + row, s);
        }
#undef EDN_LOAD
        asm volatile("s_waitcnt vmcnt(0)" ::: "memory");
        unsigned* cw = cnt + 64 * u.pm;
        if ((threadIdx.x & 63) == 0) __hip_atomic_fetch_add(cw, 1u, __ATOMIC_RELAXED, __HIP_MEMORY_SCOPE_AGENT);
        f32x4 gv[2][2];
#pragma unroll
        for (int bj = 0; bj < 2; ++bj) { gv[bj][0] = *(const f32x4*)(fg + col0 + bj * 128); gv[bj][1] = *(const f32x4*)(fg + col0 + bj * 128 + 4); }
        { unsigned spins = 0;
          while ((unsigned)__builtin_amdgcn_readfirstlane((int)__hip_atomic_load(cw, __ATOMIC_RELAXED, __HIP_MEMORY_SCOPE_AGENT)) < 64u) { __builtin_amdgcn_s_sleep(2); if (++spins > (1u << 20)) break; } }
        __builtin_amdgcn_fence(__ATOMIC_ACQUIRE, "agent");
        float tot[8];
#pragma unroll
        for (int g = 0; g < 8; ++g) tot[g] = __hip_atomic_load(ss + row0 + (g >> 2) * 128 + (g & 3) * 16, __ATOMIC_RELAXED, __HIP_MEMORY_SCOPE_AGENT);
#pragma unroll
        for (int g = 0; g < 8; ++g) {
            const int ai = g >> 2, m = g & 3, row = row0 + ai * 128 + m * 16;
            const float r = rsqrtf(tot[g] * (1.f / 2048.f) + EPS);
            float* o = out + (size_t)row * 2048 + col0;
#pragma unroll
            for (int bj = 0; bj < 2; ++bj)
#pragma unroll
                for (int n = 0; n < 2; ++n) *(f32x4*)(o + bj * 128 + 4 * n) = h[ai][bj][m][n] * r * gv[bj][n];
        }
    }
};

template <class F> __device__ __forceinline__ void gemm_naive(const bf16* __restrict__ A, const bf16* __restrict__ Bt, int M, int N, int K, const F& f, int gw, int NGW, int lane) {
    const int ntn = N / 64, ntiles = (M / 64) * ntn;
    const int r = lane & 31, h = lane >> 5;
    const int pi = 16 * (r >> 4) + 8 * ((r >> 2) & 1) + (r & 3) + 4 * ((r >> 3) & 1);
    for (int t = gw; t < ntiles; t += NGW) {
        const int row0 = (t / ntn) * 64, col0 = (t % ntn) * 64;
        f32x16 acc[2][2];
#pragma unroll
        for (int i = 0; i < 2; ++i)
#pragma unroll
            for (int j = 0; j < 2; ++j)
#pragma unroll
                for (int e = 0; e < 16; ++e) acc[i][j][e] = 0.f;
        const bf16* pa0 = Bt + (size_t)(col0 + pi) * K + 8 * h; const bf16* pa1 = pa0 + (size_t)32 * K;
        const bf16* pb0 = A + (size_t)(row0 + r) * K + 8 * h;   const bf16* pb1 = pb0 + (size_t)32 * K;
        for (int k0 = 0; k0 < K; k0 += 16) {
            const bf16x8 a0 = *(const bf16x8*)(pa0 + k0), a1 = *(const bf16x8*)(pa1 + k0), b0 = *(const bf16x8*)(pb0 + k0), b1 = *(const bf16x8*)(pb1 + k0);
            acc[0][0] = __builtin_amdgcn_mfma_f32_32x32x16_bf16(a0, b0, acc[0][0], 0, 0, 0);
            acc[0][1] = __builtin_amdgcn_mfma_f32_32x32x16_bf16(a0, b1, acc[0][1], 0, 0, 0);
            acc[1][0] = __builtin_amdgcn_mfma_f32_32x32x16_bf16(a1, b0, acc[1][0], 0, 0, 0);
            acc[1][1] = __builtin_amdgcn_mfma_f32_32x32x16_bf16(a1, b1, acc[1][1], 0, 0, 0);
        }
#pragma unroll
        for (int ni = 0; ni < 2; ++ni)
#pragma unroll
            for (int mi = 0; mi < 2; ++mi) {
                const int row = row0 + 32 * mi + r;
#pragma unroll
                for (int hf = 0; hf < 2; ++hf) {
                    const int col = col0 + 32 * ni + 16 * hf + 8 * h;
                    float v[8];
#pragma unroll
                    for (int i = 0; i < 8; ++i) v[i] = acc[ni][mi][8 * hf + i];
                    typename F::Pre pre; f.load(row, col, pre);
                    const float ss = f.apply(row, col, v, pre);
                    if (F::HAS_SS) atomicAdd(f.ss + row, ss);
                }
            }
    }
}

template <class F> __device__ __forceinline__ void gemm_run(LAS unsigned char* lds, const bf16* A, const bf16* Bt, int M, int N, int K, const F& f, int gw, int NGW, int lane) {
#if USE_PG8
    pg8::Gemm g{A, Bt, M, N, K}; pg8::StaticOrder So; So.init(M, N, (int)gridDim.x, (int)blockIdx.x);
    EpiChunk<F> E{f};
    pg8::gemm_phase<EpiChunk<F>, pg8::StaticOrder, true, true>(lds, g, So, E);
#else
    gemm_naive<F>(A, Bt, M, N, K, f, gw, NGW, lane);
#endif
}

__device__ __forceinline__ void attn_naive(LAS unsigned char* lds, const bf16* __restrict__ Q, const bf16* __restrict__ Kb, const bf16* __restrict__ Vb, bf16* CAT, int gw, int NGW, int wave, int lane) {
    LAS float* qs = (LAS float*)(lds + wave * 2304);
    LAS float* sc = qs + 128;
    for (int it = gw; it < S * NH; it += NGW) {
        const int t = it >> 3, hh = it & 7;
        { const unsigned w = *(const unsigned*)(Q + (size_t)t * 1024 + hh * 128 + 2 * lane); qs[2 * lane] = bflo(w); qs[2 * lane + 1] = bfhi(w); }
        WSYNC();
        float mx = -INFINITY;
        for (int e = lane; e < 387; e += 64) {
            const int p = e / 129, j = e - p * 129; const int d = (p == 0) ? 1 : (p == 1 ? 4 : 16);
            const int pos = t - j * d;
            float s = -INFINITY;
            if (pos >= 0) {
                const bf16* kr = Kb + (size_t)pos * 1024 + hh * 128;
                s = 0.f;
#pragma unroll 4
                for (int c = 0; c < 16; ++c) {
                    const u32x4 kw = *(const u32x4*)(kr + 8 * c);
                    const f32x4 q0 = *(const LAS f32x4*)(qs + 8 * c), q1 = *(const LAS f32x4*)(qs + 8 * c + 4);
                    s += q0[0] * bflo(kw.x) + q0[1] * bfhi(kw.x) + q0[2] * bflo(kw.y) + q0[3] * bfhi(kw.y) + q1[0] * bflo(kw.z) + q1[1] * bfhi(kw.z) + q1[2] * bflo(kw.w) + q1[3] * bfhi(kw.w);
                }
            }
            sc[e] = s; mx = fmaxf(mx, s);
        }
        mx = wave_max(mx);
        float ls = 0.f;
        for (int e = lane; e < 387; e += 64) { const float pe = exp2f(sc[e] - mx); sc[e] = pe; ls += pe; }
        ls = wave_sum(ls);
        WSYNC();
        float o0 = 0.f, o1 = 0.f;
        for (int e = 0; e < 387; ++e) {
            const float pe = sc[e];
            if (pe == 0.f) continue;
            const int p = e / 129, j = e - p * 129; const int d = (p == 0) ? 1 : (p == 1 ? 4 : 16);
            const int pos = t - j * d;
            const unsigned w = *(const unsigned*)(Vb + (size_t)pos * 1024 + hh * 128 + 2 * lane);
            o0 += pe * bflo(w); o1 += pe * bfhi(w);
        }
        const float inv = 1.f / ls;
        *(unsigned*)(CAT + (size_t)t * 2048 + hh * 128 + 2 * lane) = pk2(o0 * inv, o1 * inv);
        WSYNC();
    }
}

__device__ __forceinline__ void s5_naive(LAS unsigned char* lds, const Args& a, const bf16* __restrict__ U, bf16* Y, int g, int wave, int lane) {
    const float* a_re = a.in[3]; const float* a_im = a.in[4]; const float* log_dt = a.in[5]; const float* b_re = a.in[6]; const float* b_im = a.in[7];
    const float* c_re = a.in[8]; const float* c_im = a.in[9]; const float* d_skip = a.in[10];
    LAS float* tmp = (LAS float*)(lds + wave * 4096);
    const int n = lane;
    const float are = a_re[g * 64 + n], aim = a_im[g * 64 + n], dt = expf(log_dt[g]);
    const float er = expf(are * dt), abr = er * cosf(aim * dt), abi = er * sinf(aim * dt);
    const float nr = abr - 1.f, ni = abi, den = are * are + aim * aim;
    const float cr = (nr * are + ni * aim) / den, ci = (ni * are - nr * aim) / den;
    float bbr[16], bbi[16], ccr[16], cci[16];
#pragma unroll
    for (int p = 0; p < 16; ++p) {
        const float br = b_re[(size_t)(g * 64 + n) * 16 + p], bi = b_im[(size_t)(g * 64 + n) * 16 + p];
        bbr[p] = cr * br - ci * bi; bbi[p] = cr * bi + ci * br;
        ccr[p] = c_re[(size_t)(g * 16 + p) * 64 + n]; cci[p] = c_im[(size_t)(g * 16 + p) * 64 + n];
    }
    const int pp = lane >> 2, part = lane & 3;
    const float dsk = d_skip[g * 16 + pp];
    float hr = 0.f, hi = 0.f;
    const bf16* ug = U + (size_t)g * S * 16;
    for (int tb = 0; tb < S; tb += 8) {
        u32x4 ub[8][2];
#pragma unroll
        for (int i = 0; i < 8; ++i) { ub[i][0] = *(const u32x4*)(ug + (size_t)(tb + i) * 16); ub[i][1] = *(const u32x4*)(ug + (size_t)(tb + i) * 16 + 8); }
#pragma unroll
        for (int i = 0; i < 8; ++i) {
            float u[16];
#pragma unroll
            for (int w = 0; w < 4; ++w) { u[2 * w] = bflo(ub[i][0][w]); u[2 * w + 1] = bfhi(ub[i][0][w]); u[8 + 2 * w] = bflo(ub[i][1][w]); u[8 + 2 * w + 1] = bfhi(ub[i][1][w]); }
            float bur = 0.f, bui = 0.f;
#pragma unroll
            for (int p = 0; p < 16; ++p) { bur += bbr[p] * u[p]; bui += bbi[p] * u[p]; }
            const float nhr = abr * hr - abi * hi + bur, nhi = abr * hi + abi * hr + bui; hr = nhr; hi = nhi;
#pragma unroll
            for (int p = 0; p < 16; ++p) tmp[p * 64 + n] = ccr[p] * hr - cci[p] * hi;
            WSYNC();
            float s = 0.f;
#pragma unroll
            for (int k = 0; k < 4; ++k) { const f32x4 v = *(const LAS f32x4*)(tmp + pp * 64 + part * 16 + 4 * k); s += (v[0] + v[1]) + (v[2] + v[3]); }
            s += __shfl_xor(s, 1); s += __shfl_xor(s, 2);
            float uv = 0.f;
#pragma unroll
            for (int q = 0; q < 16; ++q) uv = (pp == q) ? u[q] : uv;
            const float y = gelu_tanh(s + dsk * uv);
            if (part == 0) Y[(size_t)(tb + i) * 1024 + g * 16 + pp] = (bf16)f2bf(y);
            WSYNC();
        }
    }
}
#define XB_TMO      128
#define XB_XCNT(j)  (256  + 64 * (j))
#define XB_XSUB(j)  (1280 + 64 * (j))
#define XB_XGEN(j)  (2304 + 64 * (j))
#define XB_TOP      3328
#define XB_TOPGEN   3392
#define XCD_BAR_WORDS 3456
#define XB_SPIN_CAP (1u << 18)

__device__ __forceinline__ unsigned xb_ld(unsigned* p)              { return __hip_atomic_load(p, __ATOMIC_RELAXED, __HIP_MEMORY_SCOPE_AGENT); }
__device__ __forceinline__ unsigned xb_add(unsigned* p, unsigned v) { return __hip_atomic_fetch_add(p, v, __ATOMIC_RELAXED, __HIP_MEMORY_SCOPE_AGENT); }
__device__ __forceinline__ unsigned xb_xcc_id() { return (unsigned)__builtin_amdgcn_s_getreg((3 << 11) | 20) & 0xFu; }
#define XB_SPIN(cond, bar) do { unsigned _sp = 0; while (cond) { __builtin_amdgcn_s_sleep(1); \
    if ((++_sp & 255u) == 0u) { if (xb_ld(&(bar)[XB_TMO])) break; if (_sp > XB_SPIN_CAP) { atomicAdd(&(bar)[XB_TMO], 1u); break; } } } } while (0)

struct XcdBarrier {
    unsigned* bar; unsigned x;
    volatile LAS unsigned* st;
};

__device__ __forceinline__ XcdBarrier xcd_barrier_post(unsigned* bar, volatile LAS unsigned* st) {
    XcdBarrier b; b.bar = bar; b.x = xb_xcc_id(); b.st = st;
    if (threadIdx.x == 0) (void)xb_add(&bar[XB_XCNT(b.x)], 1u);
    return b;
}
__device__ __forceinline__ void xcd_barrier_complete(unsigned* bar, unsigned x, unsigned& nloc, unsigned& nx) {
    const unsigned G = gridDim.x * gridDim.y * gridDim.z;
    unsigned sum, cnt, mine, sp = 0u;
    for (;;) {
        sum = 0u; cnt = 0u; mine = 0u;
#pragma unroll
        for (unsigned j = 0; j < 16; ++j) { const unsigned c = xb_ld(&bar[XB_XCNT(j)]); sum += c; cnt += (c > 0u) ? 1u : 0u; mine = (j == x) ? c : mine; }
        if (sum == G) break;
        __builtin_amdgcn_s_sleep(1);
        if ((++sp & 255u) == 0u) { if (xb_ld(&bar[XB_TMO])) break; if (sp > XB_SPIN_CAP) { atomicAdd(&bar[XB_TMO], 1u); break; } }
    }
    nloc = mine > 0u ? mine : 1u; nx = cnt > 0u ? cnt : 1u;
}

__device__ __forceinline__ void xcd_barrier(const XcdBarrier& b) {
    asm volatile("s_waitcnt vmcnt(0)" ::: "memory");
    __syncthreads();
    if (threadIdx.x == 0) {
        unsigned* bar = b.bar;
        __builtin_amdgcn_s_waitcnt(0);
        unsigned nloc = b.st[0], nx = b.st[1];
        if (nloc == 0u) { xcd_barrier_complete(bar, b.x, nloc, nx); b.st[0] = nloc; b.st[1] = nx; }
        const unsigned old = xb_add(&bar[XB_XSUB(b.x)], 1u);
        const unsigned gen = old / nloc;
        if (old + 1u == (gen + 1u) * nloc) {
            __builtin_amdgcn_fence(__ATOMIC_RELEASE, "agent");
            asm volatile("s_waitcnt vmcnt(0)" ::: "memory");
            const unsigned og = xb_add(&bar[XB_TOP], 1u);
            const unsigned tg = og / nx;
            if (og + 1u == (tg + 1u) * nx) xb_add(&bar[XB_TOPGEN], 1u);
            else XB_SPIN(xb_ld(&bar[XB_TOPGEN]) == tg, bar);
            __builtin_amdgcn_fence(__ATOMIC_ACQUIRE, "agent");
            xb_add(&bar[XB_XGEN(b.x)], 1u);
            asm volatile("s_waitcnt vmcnt(0)" ::: "memory");
        } else {
            XB_SPIN(xb_ld(&bar[XB_XGEN(b.x)]) == gen, bar);
            __builtin_amdgcn_fence(__ATOMIC_ACQUIRE, "agent");
            asm volatile("s_waitcnt vmcnt(0)" ::: "memory");
        }
    }
    __syncthreads();
}

constexpr int ST = 32, SNC = S / ST;
constexpr size_t WS_MLAG = 4 * MiB;
constexpr size_t WS_SC = 396 * MiB, WS_HP = 412 * MiB, WS_WST = 420 * MiB, WS_WC = 428 * MiB, WS_END2 = 436 * MiB;

__device__ __forceinline__ void s5_table_item(LAS unsigned char* lds, const Args& a, bf16* MLAG, bf16* WST, bf16* WC, int item, int wave, int lane) {
    const float* a_re = a.in[3]; const float* a_im = a.in[4]; const float* log_dt = a.in[5]; const float* b_re = a.in[6]; const float* b_im = a.in[7];
    const float* c_re = a.in[8]; const float* c_im = a.in[9];
    const int g = item >> 5, tau = item & 31, n = lane;
    LAS float* zs = (LAS float*)(lds + wave * 18432);
    const float are = a_re[g * 64 + n], aim = a_im[g * 64 + n], dt = expf(log_dt[g]);
    const float er = expf(are * dt), abr = er * cosf(aim * dt), abi = er * sinf(aim * dt);
    const float e0 = expf(are * dt * (float)tau), w0r = e0 * cosf(aim * dt * (float)tau), w0i = e0 * sinf(aim * dt * (float)tau);
    const float e1 = expf(are * dt * (float)(tau + 1)), w1r = e1 * cosf(aim * dt * (float)(tau + 1)), w1i = e1 * sinf(aim * dt * (float)(tau + 1));
    const float nr = abr - 1.f, ni = abi, den = are * are + aim * aim;
    const float cr = (nr * are + ni * aim) / den, ci = (ni * are - nr * aim) / den;
    float zr[16], zi[16];
#pragma unroll
    for (int q = 0; q < 16; ++q) {
        const float br = b_re[(size_t)(g * 64 + n) * 16 + q], bi = b_im[(size_t)(g * 64 + n) * 16 + q];
        const float bbr = cr * br - ci * bi, bbi = cr * bi + ci * br;
        zr[q] = w0r * bbr - w0i * bbi; zi[q] = w0r * bbi + w0i * bbr;
        zs[n * 16 + q] = zr[q]; zs[1024 + n * 16 + q] = zi[q];
    }
    {
        const int i = 31 - tau;
        bf16* d0 = WST + ((size_t)g * 128 + n) * 512 + i * 16; bf16* d1 = d0 + (size_t)64 * 512;
        u32x4 o;
        o.x = pk2(zr[0], zr[1]); o.y = pk2(zr[2], zr[3]); o.z = pk2(zr[4], zr[5]); o.w = pk2(zr[6], zr[7]); *(u32x4*)d0 = o;
        o.x = pk2(zr[8], zr[9]); o.y = pk2(zr[10], zr[11]); o.z = pk2(zr[12], zr[13]); o.w = pk2(zr[14], zr[15]); *(u32x4*)(d0 + 8) = o;
        o.x = pk2(zi[0], zi[1]); o.y = pk2(zi[2], zi[3]); o.z = pk2(zi[4], zi[5]); o.w = pk2(zi[6], zi[7]); *(u32x4*)d1 = o;
        o.x = pk2(zi[8], zi[9]); o.y = pk2(zi[10], zi[11]); o.z = pk2(zi[12], zi[13]); o.w = pk2(zi[14], zi[15]); *(u32x4*)(d1 + 8) = o;
    }
#pragma unroll
    for (int p = 0; p < 16; ++p) {
        const float cre = c_re[(size_t)(g * 16 + p) * 64 + n], cim = c_im[(size_t)(g * 16 + p) * 64 + n];
        bf16* d = WC + ((size_t)g * 512 + tau * 16 + p) * 128;
        d[n] = (bf16)f2bf(cre * w1r - cim * w1i); d[64 + n] = (bf16)f2bf(-(cre * w1i + cim * w1r));
        zs[2048 + p * 64 + n] = cre; zs[3072 + p * 64 + n] = cim;
    }
    WSYNC();
    {
        const int p = lane >> 2, q0 = 4 * (lane & 3);
        const LAS float* crp = zs + 2048 + p * 64; const LAS float* cip = zs + 3072 + p * 64;
        float acc[4] = {0.f, 0.f, 0.f, 0.f};
#pragma unroll 8
        for (int m = 0; m < 64; ++m) {
            const float cre = crp[m], cim = cip[m];
            const f32x4 vr = *(const LAS f32x4*)(zs + m * 16 + q0), vi = *(const LAS f32x4*)(zs + 1024 + m * 16 + q0);
#pragma unroll
            for (int i = 0; i < 4; ++i) acc[i] += cre * vr[i] - cim * vi[i];
        }
        u32x2 o; o.x = pk2(acc[0], acc[1]); o.y = pk2(acc[2], acc[3]);
        *(u32x2*)(MLAG + ((size_t)g * 32 + tau) * 256 + p * 16 + q0) = o;
    }
    WSYNC();
}

__device__ __forceinline__ void s5_state_item(const bf16* __restrict__ WST, const bf16* __restrict__ U, float* SC, int item, int lane) {
    const int half = item & 1, g = item >> 5, ct = (item >> 1) & 15, r = lane & 31, h = lane >> 5, c = ct * 32 + r;
    f32x16 acc[2];
#pragma unroll
    for (int i = 0; i < 2; ++i)
#pragma unroll
        for (int e = 0; e < 16; ++e) acc[i][e] = 0.f;
    const bf16* ub = U + ((size_t)g * S + (size_t)c * 32) * 16 + 8 * h;
    const bf16* wb = WST + ((size_t)g * 128 + 64 * half + r) * 512 + 8 * h;
#pragma unroll 8
    for (int ks = 0; ks < 32; ++ks) {
        const bf16x8 b = *(const bf16x8*)(ub + ks * 16);
#pragma unroll
        for (int rt = 0; rt < 2; ++rt) { const bf16x8 av = *(const bf16x8*)(wb + (size_t)rt * 32 * 512 + ks * 16); acc[rt] = __builtin_amdgcn_mfma_f32_32x32x16_bf16(av, b, acc[rt], 0, 0, 0); }
    }
    float* o = SC + ((size_t)g * SNC + c) * 128 + 64 * half;
#pragma unroll
    for (int rt = 0; rt < 2; ++rt)
#pragma unroll
        for (int eg = 0; eg < 4; ++eg) { f32x4 v = {acc[rt][4 * eg], acc[rt][4 * eg + 1], acc[rt][4 * eg + 2], acc[rt][4 * eg + 3]}; *(f32x4*)(o + 32 * rt + 8 * eg + 4 * h) = v; }
}

__device__ __forceinline__ void s5_state_block(LAS unsigned char* lds, const bf16* __restrict__ WST, const bf16* __restrict__ U, float* SC, int vb, int tid, int wave, int lane) {
    constexpr int WROW = 1040;
    const int g = vb >> 2;
    __syncthreads();
    { const u32x4* src = (const u32x4*)(WST + (size_t)g * 128 * 512);
      u32x4 tmp[16];
#pragma unroll
      for (int i = 0; i < 16; ++i) tmp[i] = src[tid + 512 * i];
#pragma unroll
      for (int i = 0; i < 16; ++i) { const int chunk = tid + 512 * i, row = chunk >> 6, ch = chunk & 63; *(LAS u32x4*)(lds + row * WROW + ch * 16) = tmp[i]; } }
    __syncthreads();
    const int half = wave & 1, ct = 4 * (vb & 3) + (wave >> 1), r = lane & 31, h = lane >> 5, c = ct * 32 + r;
    f32x16 acc[2];
#pragma unroll
    for (int i = 0; i < 2; ++i)
#pragma unroll
        for (int e = 0; e < 16; ++e) acc[i][e] = 0.f;
    const bf16* ub = U + ((size_t)g * S + (size_t)c * 32) * 16 + 8 * h;
    const LAS unsigned char* wl = lds + (64 * half + r) * WROW + h * 16;
    bf16x8 bfr[32];
#pragma unroll
    for (int ks = 0; ks < 32; ++ks) bfr[ks] = *(const bf16x8*)(ub + ks * 16);
#pragma unroll
    for (int ks = 0; ks < 32; ++ks) {
#pragma unroll
        for (int rt = 0; rt < 2; ++rt) { const bf16x8 av = *(const LAS bf16x8*)(wl + rt * 32 * WROW + ks * 32); acc[rt] = __builtin_amdgcn_mfma_f32_32x32x16_bf16(av, bfr[ks], acc[rt], 0, 0, 0); }
    }
    float* o = SC + ((size_t)g * SNC + c) * 128 + 64 * half;
#pragma unroll
    for (int rt = 0; rt < 2; ++rt)
#pragma unroll
        for (int eg = 0; eg < 4; ++eg) { f32x4 v = {acc[rt][4 * eg], acc[rt][4 * eg + 1], acc[rt][4 * eg + 2], acc[rt][4 * eg + 3]}; *(f32x4*)(o + 32 * rt + 8 * eg + 4 * h) = v; }
}

__device__ __forceinline__ void s5_state_block2(LAS unsigned char* lds, const bf16* __restrict__ WST, const bf16* __restrict__ U, float* SC, int vb, int tid, int wave, int lane) {
    constexpr int PR = 528, UOFF2 = 128 * PR;
    const int g = vb >> 2, ct0 = 4 * (vb & 3);
    const int half = wave & 1, ctl = wave >> 1, r = lane & 31, h = lane >> 5;
    f32x16 acc[2];
#pragma unroll
    for (int i = 0; i < 2; ++i)
#pragma unroll
        for (int e = 0; e < 16; ++e) acc[i][e] = 0.f;
    const LAS unsigned char* wl = lds + (64 * half + r) * PR + h * 16;
    const LAS unsigned char* ul = lds + UOFF2 + (ctl * 32 + r) * PR + h * 16;
#pragma unroll 1
    for (int kh = 0; kh < 2; ++kh) {
        u32x4 tw[8], tu[8];
#pragma unroll
        for (int i = 0; i < 8; ++i) { const int idx = tid + 512 * i, row = idx >> 5, pc = idx & 31;
            tw[i] = *(const u32x4*)(WST + ((size_t)g * 128 + row) * 512 + kh * 256 + pc * 8);
            tu[i] = *(const u32x4*)(U + ((size_t)g * S + (size_t)(ct0 * 32 + row) * 32 + kh * 16) * 16 + pc * 8); }
        __syncthreads();
#pragma unroll
        for (int i = 0; i < 8; ++i) { const int idx = tid + 512 * i, row = idx >> 5, pc = idx & 31;
            *(LAS u32x4*)(lds + row * PR + pc * 16) = tw[i]; *(LAS u32x4*)(lds + UOFF2 + row * PR + pc * 16) = tu[i]; }
        __syncthreads();
#pragma unroll
        for (int ksl = 0; ksl < 16; ++ksl) {
            const bf16x8 bv = *(const LAS bf16x8*)(ul + 32 * ksl);
#pragma unroll
            for (int rt = 0; rt < 2; ++rt) { const bf16x8 av = *(const LAS bf16x8*)(wl + rt * 32 * PR + 32 * ksl); acc[rt] = __builtin_amdgcn_mfma_f32_32x32x16_bf16(av, bv, acc[rt], 0, 0, 0); }
        }
    }
    const int c = (ct0 + ctl) * 32 + r;
    float* o = SC + ((size_t)g * SNC + c) * 128 + 64 * half;
#pragma unroll
    for (int rt = 0; rt < 2; ++rt)
#pragma unroll
        for (int eg = 0; eg < 4; ++eg) { f32x4 v = {acc[rt][4 * eg], acc[rt][4 * eg + 1], acc[rt][4 * eg + 2], acc[rt][4 * eg + 3]}; *(f32x4*)(o + 32 * rt + 8 * eg + 4 * h) = v; }
}

__device__ __forceinline__ void s5_scan_block(LAS unsigned char* lds, const Args& a, const float* __restrict__ SC, bf16* HP, int g, int wave, int lane) {
    const int n = lane;
    const float are = a.in[3][g * 64 + n], aim = a.in[4][g * 64 + n], dt = expf(a.in[5][g]);
    const float eT = expf(are * dt * (float)ST), atr = eT * cosf(aim * dt * (float)ST), ati = eT * sinf(aim * dt * (float)ST);
    const float eS = expf(are * dt * (float)(ST * 64)), asr = eS * cosf(aim * dt * (float)(ST * 64)), asi = eS * sinf(aim * dt * (float)(ST * 64));
    const int c0 = wave * 64;
    const float* sc = SC + ((size_t)g * SNC + c0) * 128; bf16* hp = HP + ((size_t)g * SNC + c0) * 128;
    LAS float* ex = (LAS float*)lds;
    float sr0[16], si0[16];
#define S5_LOAD(SR, SI, cb) do { _Pragma("unroll") for (int i = 0; i < 16; ++i) { SR[i] = sc[(size_t)((cb) + i) * 128 + n]; SI[i] = sc[(size_t)((cb) + i) * 128 + 64 + n]; } } while (0)
#define S5_ACC(SR, SI) do { _Pragma("unroll") for (int i = 0; i < 16; ++i) { const float nhr = atr * hr - ati * hi + SR[i], nhi = atr * hi + ati * hr + SI[i]; hr = nhr; hi = nhi; } } while (0)
#define S5_STEP(SR, SI, cb) do { _Pragma("unroll") for (int i = 0; i < 16; ++i) { \
        hp[(size_t)((cb) + i) * 128 + n] = (bf16)f2bf(hr); hp[(size_t)((cb) + i) * 128 + 64 + n] = (bf16)f2bf(hi); \
        const float nhr = atr * hr - ati * hi + SR[i], nhi = atr * hi + ati * hr + SI[i]; hr = nhr; hi = nhi; } } while (0)
    float hr = 0.f, hi = 0.f;
    for (int cb = 0; cb < 64; cb += 16) { S5_LOAD(sr0, si0, cb); S5_ACC(sr0, si0); }
    __syncthreads();
    ex[wave * 128 + n] = hr; ex[wave * 128 + 64 + n] = hi;
    __syncthreads();
    hr = 0.f; hi = 0.f;
    for (int w = 0; w < wave; ++w) { const float er = ex[w * 128 + n], ei = ex[w * 128 + 64 + n]; const float nhr = asr * hr - asi * hi + er, nhi = asr * hi + asi * hr + ei; hr = nhr; hi = nhi; }
    for (int cb = 0; cb < 64; cb += 16) { S5_LOAD(sr0, si0, cb); S5_STEP(sr0, si0, cb); }
#undef S5_LOAD
#undef S5_ACC
#undef S5_STEP
}

__device__ __forceinline__ void s5_out_block(LAS unsigned char* lds, const bf16* __restrict__ MLAG, const bf16* __restrict__ WC, const bf16* __restrict__ HP, const bf16* __restrict__ U,
                                             const float* __restrict__ d_skip, bf16* Y, int vb, int tid, int wave, int lane) {
    const int g = vb >> 2, ct = 4 * (vb & 3) + (wave >> 1), half = wave & 1;
    __syncthreads();
    { const u32x4* src = (const u32x4*)(MLAG + (size_t)g * 8192); LAS u32x4* dst = (LAS u32x4*)lds; dst[tid] = src[tid]; dst[tid + 512] = src[tid + 512]; }
    __syncthreads();
    const int r = lane & 31, h = lane >> 5, c = ct * 32 + r, rj = r >> 4, rp = r & 15;
    const bf16* ub = U + ((size_t)g * S + (size_t)c * 32) * 16 + 8 * h;
    const bf16* hpb = HP + ((size_t)g * SNC + c) * 128 + 8 * h;
    bf16x8 hp[8];
#pragma unroll
    for (int ks = 0; ks < 8; ++ks) hp[ks] = *(const bf16x8*)(hpb + 16 * ks);
    const LAS unsigned char* ml = lds + rp * 32 + h * 16;
    for (int pass = 0; pass < 2; ++pass) {
        const int jg = half ? (1 + pass) : (3 * pass);
        f32x16 acc[4];
#pragma unroll
        for (int i = 0; i < 4; ++i)
#pragma unroll
            for (int e = 0; e < 16; ++e) acc[i][e] = 0.f;
#pragma unroll
        for (int jl = 0; jl < 4; ++jl) {
            const bf16* wcb = WC + ((size_t)g * 512 + (4 * jg + jl) * 32 + r) * 128 + 8 * h;
#pragma unroll
            for (int ks = 0; ks < 8; ++ks) { const bf16x8 av = *(const bf16x8*)(wcb + 16 * ks); acc[jl] = __builtin_amdgcn_mfma_f32_32x32x16_bf16(av, hp[ks], acc[jl], 0, 0, 0); }
        }
        const int nkb = jg + 1;
        bf16x8 bA[8], bB[8];
#define S5_BLOAD(BF, kb) do { _Pragma("unroll") for (int q_ = 0; q_ < 8; ++q_) BF[q_] = *(const bf16x8*)(ub + ((kb) * 8 + q_) * 16); } while (0)
#define S5_BMMA(BF, kb) do { _Pragma("unroll") for (int q_ = 0; q_ < 8; ++q_) { const int ks = (kb) * 8 + q_; \
            _Pragma("unroll") for (int jl = 0; jl < 4; ++jl) { const int jj = 4 * jg + jl; \
                if (2 * jj + 1 - ks >= 0) { const int tau = 2 * jj + rj - ks; const int tc = tau < 0 ? 0 : tau; \
                    bf16x8 av = *(const LAS bf16x8*)(ml + tc * 512); if (tau < 0) av = (bf16x8){0, 0, 0, 0, 0, 0, 0, 0}; \
                    acc[jl] = __builtin_amdgcn_mfma_f32_32x32x16_bf16(av, BF[q_], acc[jl], 0, 0, 0); } } } } while (0)
        S5_BLOAD(bA, 0);
        for (int kb = 0; kb < nkb; kb += 2) {
            if (kb + 1 < nkb) S5_BLOAD(bB, kb + 1);
            S5_BMMA(bA, kb);
            if (kb + 1 < nkb) {
                if (kb + 2 < nkb) S5_BLOAD(bA, kb + 2);
                S5_BMMA(bB, kb + 1);
            }
        }
#undef S5_BLOAD
#undef S5_BMMA
#pragma unroll
        for (int jl = 0; jl < 4; ++jl)
#pragma unroll
            for (int eg = 0; eg < 4; ++eg) {
                const int j = 2 * (4 * jg + jl) + (eg >> 1), p0 = 8 * (eg & 1) + 4 * h, t = c * 32 + j;
                const u32x2 uw = *(const u32x2*)(U + ((size_t)g * S + t) * 16 + p0);
                const f32x4 d = *(const f32x4*)(d_skip + g * 16 + p0);
                const float y0 = gelu_tanh(acc[jl][4 * eg + 0] + d[0] * bflo(uw.x)), y1 = gelu_tanh(acc[jl][4 * eg + 1] + d[1] * bfhi(uw.x));
                const float y2 = gelu_tanh(acc[jl][4 * eg + 2] + d[2] * bflo(uw.y)), y3 = gelu_tanh(acc[jl][4 * eg + 3] + d[3] * bfhi(uw.y));
                u32x2 o; o.x = pk2(y0, y1); o.y = pk2(y2, y3);
                *(u32x2*)(Y + (size_t)t * 1024 + g * 16 + p0) = o;
            }
    }
}

__device__ __forceinline__ void s5_out_block2(LAS unsigned char* lds, const bf16* __restrict__ MLAG, const bf16* __restrict__ WC, const bf16* __restrict__ HP, const bf16* __restrict__ U,
                                              const float* __restrict__ d_skip, bf16* Y, int vb, int tid, int wave, int lane) {
    constexpr int UOFF = 16384, UROW = 1040, HOFF = UOFF + 32 * UROW, HROW = 272;
    const int g = vb >> 2;
    const int r = lane & 31, h = lane >> 5, rj = r >> 4, rp = r & 15;
    __syncthreads();
    { const u32x4* src = (const u32x4*)(MLAG + (size_t)g * 8192); LAS u32x4* dst = (LAS u32x4*)lds; dst[tid] = src[tid]; dst[tid + 512] = src[tid + 512]; }
    const LAS unsigned char* ml = lds + rp * 32 + h * 16;
    const LAS unsigned char* ul = lds + UOFF + r * UROW + h * 16;
    const LAS unsigned char* hl = lds + HOFF + r * HROW + h * 16;
    const f32x4 dA = *(const f32x4*)(d_skip + g * 16 + 4 * h), dB = *(const f32x4*)(d_skip + g * 16 + 8 + 4 * h);
    bf16x8 wc[2][8];
#pragma unroll
    for (int q = 0; q < 2; ++q) { const int jj = q ? 15 - wave : wave; const bf16* wcb = WC + ((size_t)g * 512 + jj * 32 + r) * 128 + 8 * h;
#pragma unroll
        for (int ks = 0; ks < 8; ++ks) wc[q][ks] = *(const bf16x8*)(wcb + 16 * ks); }
    for (int it = 0; it < 4; ++it) {
        const int ct = 4 * (vb & 3) + it;
        __syncthreads();
        { const u32x4* us = (const u32x4*)(U + ((size_t)g * S + (size_t)ct * 1024) * 16);
#pragma unroll
          for (int i = 0; i < 4; ++i) { const int idx = tid + 512 * i; *(LAS u32x4*)(lds + UOFF + (idx >> 6) * UROW + (idx & 63) * 16) = us[idx]; }
          const u32x4* hs = (const u32x4*)(HP + ((size_t)g * SNC + ct * 32) * 128);
          *(LAS u32x4*)(lds + HOFF + (tid >> 4) * HROW + (tid & 15) * 16) = hs[tid]; }
        __syncthreads();
#pragma unroll
        for (int q = 0; q < 2; ++q) {
            const int jj = q ? 15 - wave : wave;
            f32x16 acc;
#pragma unroll
            for (int e = 0; e < 16; ++e) acc[e] = 0.f;
#pragma unroll
            for (int ks = 0; ks < 8; ++ks) { const bf16x8 bv = *(const LAS bf16x8*)(hl + 32 * ks); acc = __builtin_amdgcn_mfma_f32_32x32x16_bf16(wc[q][ks], bv, acc, 0, 0, 0); }
            const int kend = 2 * jj + 2;
#pragma unroll 2
            for (int ks = 0; ks < kend; ++ks) {
                const bf16x8 bv = *(const LAS bf16x8*)(ul + 32 * ks);
                const int tau = 2 * jj + rj - ks; const int tc = tau < 0 ? 0 : tau;
                bf16x8 av = *(const LAS bf16x8*)(ml + tc * 512); if (tau < 0) av = (bf16x8){0, 0, 0, 0, 0, 0, 0, 0};
                acc = __builtin_amdgcn_mfma_f32_32x32x16_bf16(av, bv, acc, 0, 0, 0);
            }
            const int c = ct * 32 + r;
#pragma unroll
            for (int ep = 0; ep < 2; ++ep) {
                const int j = 2 * jj + ep, t = c * 32 + j;
                unsigned pk[2][2];
#pragma unroll
                for (int q2 = 0; q2 < 2; ++q2) {
                    const int eg = 2 * ep + q2, p0 = 8 * q2 + 4 * h;
                    const u32x2 uw = *(const LAS u32x2*)(lds + UOFF + r * UROW + j * 32 + p0 * 2);
                    const f32x4 d = q2 ? dB : dA;
                    const float y0 = gelu_tanh(acc[4 * eg + 0] + d[0] * bflo(uw.x)), y1 = gelu_tanh(acc[4 * eg + 1] + d[1] * bfhi(uw.x));
                    const float y2 = gelu_tanh(acc[4 * eg + 2] + d[2] * bflo(uw.y)), y3 = gelu_tanh(acc[4 * eg + 3] + d[3] * bfhi(uw.y));
                    pk[q2][0] = pk2(y0, y1); pk[q2][1] = pk2(y2, y3);
                }
                { auto rx = __builtin_amdgcn_permlane32_swap(pk[0][0], pk[1][0], false, false); pk[0][0] = rx[0]; pk[1][0] = rx[1]; }
                { auto ry = __builtin_amdgcn_permlane32_swap(pk[0][1], pk[1][1], false, false); pk[0][1] = ry[0]; pk[1][1] = ry[1]; }
                u32x4 o = {pk[0][0], pk[0][1], pk[1][0], pk[1][1]};
                *(u32x4*)(Y + (size_t)t * 1024 + g * 16 + 8 * h) = o;
            }
        }
    }
}

constexpr size_t WS_PM = 5 * MiB, WS_END3 = 500 * MiB;
__device__ __forceinline__ bf16* po_base(unsigned char* ws, int pat) { return (bf16*)(ws + (pat < 2 ? 436 * MiB + (size_t)pat * 32 * MiB : WS_Y)); }
constexpr int VROW = 320;
typedef short v4i16_t __attribute__((ext_vector_type(4)));
typedef short s16x4 __attribute__((ext_vector_type(4)));
__device__ __forceinline__ unsigned cvtpk_s(float lo, float hi) { return pk2(lo, hi); }
__device__ __forceinline__ s16x4 vtr(const LAS unsigned char* p) { return __builtin_bit_cast(s16x4, __builtin_amdgcn_ds_read_tr16_b64_v4i16((LAS v4i16_t*)p)); }

constexpr int KROW = 272;
struct AttnItem { int pat, hh, d, res, lq0; };
__device__ __forceinline__ AttnItem attn_decode(int item) {
    AttnItem I; I.pat = item >> 9; const int rem = item & 511, x = rem >> 3, shift = 2 * I.pat, nsb = 64 >> shift;
    I.hh = rem & 7; I.d = 1 << shift; I.res = x >> (6 - shift); I.lq0 = (x & (nsb - 1)) * 256; return I;
}
__device__ __forceinline__ AttnItem attn_item_xcd(int b, int k) {
    const int xcd = b & 7, lc = b >> 3;
    int j, t;
    if (k < 4) { j = k; t = lc; } else { j = (lc >> 4) + 2 * (k - 4); t = 32 + (lc & 15); }
    const int p = xcd * 4 + j, hh = p & 7, region = p >> 3;
    AttnItem I; I.hh = hh;
    if (t < 16)      { I.pat = 0; I.d = 1;  I.res = 0;             I.lq0 = (16 * region + t) * 256; }
    else if (t < 32) { I.pat = 1; I.d = 4;  I.res = (t - 16) >> 2; I.lq0 = (4 * region + ((t - 16) & 3)) * 256; }
    else             { I.pat = 2; I.d = 16; I.res = t - 32;        I.lq0 = region * 256; }
    return I;
}
__device__ __forceinline__ void attn_phase(LAS unsigned char* lds, const bf16* __restrict__ Q, const bf16* __restrict__ Kb, const bf16* __restrict__ Vb, unsigned char* ws, float* PM, int tid, int wave, int lane) {
    const int r = lane & 31, h = lane >> 5;
    const bool xl = (gridDim.x == 256);
    const int nit = xl ? 6 : ((1536 - (int)blockIdx.x + (int)gridDim.x - 1) / (int)gridDim.x);
    if (nit <= 0) return;
    int it = 0;
    AttnItem I = xl ? attn_item_xcd((int)blockIdx.x, 0) : attn_decode((int)blockIdx.x);
    u32x4 stg[12]; bf16x8 qf[8];
#define ATT_STAGE_LOAD(SRC, IT) do { _Pragma("unroll") for (int i_ = 0; i_ < 12; ++i_) { const int chunk_ = tid + 512 * i_, rr_ = chunk_ >> 4, ch_ = chunk_ & 15, lv_ = (IT).lq0 - 128 + rr_; \
        u32x4 val_ = {0u, 0u, 0u, 0u}; if (lv_ >= 0) val_ = *(const u32x4*)((SRC) + ((size_t)lv_ * (IT).d + (IT).res) * 1024 + (IT).hh * 128 + ch_ * 8); stg[i_] = val_; } } while (0)
#define ATT_STAGE_WRITE(ROWB) do { _Pragma("unroll") for (int i_ = 0; i_ < 12; ++i_) { const int chunk_ = tid + 512 * i_, rr_ = chunk_ >> 4, ch_ = chunk_ & 15; *(LAS u32x4*)(lds + rr_ * (ROWB) + ch_ * 16) = stg[i_]; } } while (0)
#define ATT_QLOAD(IT) do { const size_t qp_ = (size_t)((IT).lq0 + 32 * wave + r) * (IT).d + (IT).res; const bf16* q_ = Q + qp_ * 1024 + (IT).hh * 128 + 8 * h; \
        _Pragma("unroll") for (int s_ = 0; s_ < 8; ++s_) qf[s_] = *(const bf16x8*)(q_ + 16 * s_); } while (0)
    ATT_STAGE_LOAD(Kb, I); ATT_QLOAD(I);
    for (;;) {
        __syncthreads();
        ATT_STAGE_WRITE(KROW);
        __syncthreads();
        ATT_STAGE_LOAD(Vb, I);
        f32x16 sacc[5];
        const LAS unsigned char* kb = lds + (32 * wave + r) * KROW + h * 16;
        const int lkw = I.lq0 - 128 + 32 * wave;
#pragma unroll
        for (int i = 0; i < 5; ++i) {
#pragma unroll
            for (int e = 0; e < 16; ++e) sacc[i][e] = 0.f;
#pragma unroll
            for (int s = 0; s < 8; ++s) { const bf16x8 kf = *(const LAS bf16x8*)(kb + (32 * i) * KROW + 32 * s); sacc[i] = __builtin_amdgcn_mfma_f32_32x32x16_bf16(kf, qf[s], sacc[i], 0, 0, 0); }
        }
#pragma unroll
        for (int e = 0; e < 16; ++e) { const int kv = (e & 3) + 8 * (e >> 2) + 4 * h; if (kv < r) sacc[0][e] = -INFINITY; if (kv > r) sacc[4][e] = -INFINITY; }
#pragma unroll
        for (int i = 0; i < 4; ++i) if (lkw + 32 * i < 0) {
#pragma unroll
            for (int e = 0; e < 16; ++e) sacc[i][e] = -INFINITY;
        }
        float m = sacc[4][0];
#pragma unroll
        for (int i = 0; i < 5; ++i)
#pragma unroll
            for (int e = 0; e < 16; ++e) m = fmaxf(m, sacc[i][e]);
        { auto rr = __builtin_amdgcn_permlane32_swap(__float_as_uint(m), __float_as_uint(m), false, false); m = fmaxf(__uint_as_float(rr[0]), __uint_as_float(rr[1])); }
        float l = 0.f; u32x4 pw[5][2];
#pragma unroll
        for (int i = 0; i < 5; ++i) {
#pragma unroll
            for (int e = 0; e < 16; ++e) { sacc[i][e] = __builtin_amdgcn_exp2f(sacc[i][e] - m); l += sacc[i][e]; }
#pragma unroll
            for (int s2 = 0; s2 < 2; ++s2) { pw[i][s2].x = pk2(sacc[i][8 * s2], sacc[i][8 * s2 + 1]); pw[i][s2].y = pk2(sacc[i][8 * s2 + 2], sacc[i][8 * s2 + 3]); pw[i][s2].z = pk2(sacc[i][8 * s2 + 4], sacc[i][8 * s2 + 5]); pw[i][s2].w = pk2(sacc[i][8 * s2 + 6], sacc[i][8 * s2 + 7]); }
        }
        { auto rr = __builtin_amdgcn_permlane32_swap(__float_as_uint(l), __float_as_uint(l), false, false); l = __uint_as_float(rr[0]) + __uint_as_float(rr[1]); }
        __syncthreads();
        ATT_STAGE_WRITE(VROW);
        __syncthreads();
        const AttnItem C = I;
        const int nxt = it + 1; const bool more = nxt < nit;
        if (more) { I = xl ? attn_item_xcd((int)blockIdx.x, nxt) : attn_decode((int)blockIdx.x + nxt * (int)gridDim.x); ATT_STAGE_LOAD(Kb, I); ATT_QLOAD(I); }
        f32x16 oacc[4];
#pragma unroll
        for (int i = 0; i < 4; ++i)
#pragma unroll
            for (int e = 0; e < 16; ++e) oacc[i][e] = 0.f;
        const LAS unsigned char* vbase = lds + (32 * wave + 4 * h + ((lane & 15) >> 2)) * VROW + (16 * ((lane >> 4) & 1) + 4 * (lane & 3)) * 2;
#pragma unroll
        for (int i = 0; i < 5; ++i)
#pragma unroll
            for (int s2 = 0; s2 < 2; ++s2)
#pragma unroll
                for (int db = 0; db < 4; ++db) {
                    const s16x4 lo = vtr(vbase + (32 * i + 16 * s2) * VROW + db * 64), hi = vtr(vbase + (32 * i + 16 * s2 + 8) * VROW + db * 64);
                    const bf16x8 av = {lo[0], lo[1], lo[2], lo[3], hi[0], hi[1], hi[2], hi[3]};
                    oacc[db] = __builtin_amdgcn_mfma_f32_32x32x16_bf16(av, __builtin_bit_cast(bf16x8, pw[i][s2]), oacc[db], 0, 0, 0);
                }
        const float inv = 1.f / l;
        const size_t qpos = (size_t)(C.lq0 + 32 * wave + r) * C.d + C.res;
        unsigned char* po = (unsigned char*)(po_base(ws, C.pat) + qpos * 1024 + C.hh * 128) + (h ? 16 : 0);
#pragma unroll
        for (int db = 0; db < 4; ++db)
#pragma unroll
            for (int ep = 0; ep < 2; ++ep) {
                const int e0 = 2 * ep, e1 = 2 * ep + 1;
                unsigned ax = pk2(oacc[db][4 * e0] * inv, oacc[db][4 * e0 + 1] * inv), ay = pk2(oacc[db][4 * e0 + 2] * inv, oacc[db][4 * e0 + 3] * inv);
                unsigned bx = pk2(oacc[db][4 * e1] * inv, oacc[db][4 * e1 + 1] * inv), by = pk2(oacc[db][4 * e1 + 2] * inv, oacc[db][4 * e1 + 3] * inv);
                { auto rx = __builtin_amdgcn_permlane32_swap(ax, bx, false, false); ax = rx[0]; bx = rx[1]; }
                { auto ry = __builtin_amdgcn_permlane32_swap(ay, by, false, false); ay = ry[0]; by = ry[1]; }
                u32x4 o = {ax, ay, bx, by};
                *(u32x4*)(po + 16 * (4 * db + e0)) = o;
            }
        if (h == 0) { f32x2_t ml = {m, l}; *(f32x2_t*)(PM + (((size_t)C.pat * S + qpos) * 8 + C.hh) * 2) = ml; }
        if (!more) break;
        it = nxt;
    }
#undef ATT_STAGE_LOAD
#undef ATT_STAGE_WRITE
#undef ATT_QLOAD
}

__device__ __forceinline__ void attn_combine(unsigned char* ws, const float* __restrict__ PM, bf16* CAT, int gtid, int gthreads, int iend = S * 128) {
    for (int idx = gtid; idx < iend; idx += gthreads) {
        const int t = idx >> 7, c = (idx & 127) * 8, hh = c >> 7;
        float mm[3], ll[3];
#pragma unroll
        for (int p = 0; p < 3; ++p) { const f32x2_t ml = *(const f32x2_t*)(PM + (((size_t)p * S + t) * 8 + hh) * 2); mm[p] = ml[0]; ll[p] = ml[1]; }
        const float ma = fmaxf(mm[0], fmaxf(mm[1], mm[2]));
        float w[3], den = 0.f;
#pragma unroll
        for (int p = 0; p < 3; ++p) { w[p] = exp2f(mm[p] - ma) * ll[p]; den += w[p]; }
        const float inv = 1.f / den;
        float o[8] = {0.f, 0.f, 0.f, 0.f, 0.f, 0.f, 0.f, 0.f};
#pragma unroll
        for (int p = 0; p < 3; ++p) {
            const u32x4 v = *(const u32x4*)(po_base(ws, p) + (size_t)t * 1024 + c); const float wp = w[p] * inv;
            o[0] += wp * bflo(v.x); o[1] += wp * bfhi(v.x); o[2] += wp * bflo(v.y); o[3] += wp * bfhi(v.y); o[4] += wp * bflo(v.z); o[5] += wp * bfhi(v.z); o[6] += wp * bflo(v.w); o[7] += wp * bfhi(v.w);
        }
        u32x4 ov; ov.x = pk2(o[0], o[1]); ov.y = pk2(o[2], o[3]); ov.z = pk2(o[4], o[5]); ov.w = pk2(o[6], o[7]);
        *(u32x4*)(CAT + (size_t)t * 2048 + c) = ov;
    }
}
__global__ void __launch_bounds__(512, 2) mega(Args a) {
    extern __shared__ __attribute__((aligned(16))) unsigned char lds_raw[];
    LAS unsigned char* lds = (LAS unsigned char*)lds_raw;
    const int tid = threadIdx.x, lane = tid & 63, wave = __builtin_amdgcn_readfirstlane(tid >> 6);
    const int gw = blockIdx.x * 8 + wave, NGW = gridDim.x * 8;
    unsigned char* ws = a.ws;
    float* SS2 = (float*)(ws + WS_SS2); float* SS3 = (float*)(ws + WS_SS3); float* R1 = (float*)(ws + WS_R1);
    float* RC = (float*)(ws + WS_ROPEC); float* RS = (float*)(ws + WS_ROPES);
    bf16* WIN = (bf16*)(ws + WS_WIN); bf16* WGLU = (bf16*)(ws + WS_WGLU); bf16* WOUT = (bf16*)(ws + WS_WOUT); bf16* WGU = (bf16*)(ws + WS_WGU); bf16* WDN = (bf16*)(ws + WS_WDN);
    bf16* XB = (bf16*)(ws + WS_XB); bf16* Qb = (bf16*)(ws + WS_Q); bf16* Kb = (bf16*)(ws + WS_K); bf16* Vb = (bf16*)(ws + WS_V); bf16* Ub = (bf16*)(ws + WS_U);
    bf16* Yb = (bf16*)(ws + WS_Y); bf16* CAT = (bf16*)(ws + WS_CAT); bf16* HH = (bf16*)(ws + WS_HH);
    bf16* MLAG = (bf16*)(ws + WS_MLAG); bf16* WST = (bf16*)(ws + WS_WST); bf16* WC = (bf16*)(ws + WS_WC); float* SC = (float*)(ws + WS_SC); bf16* HP = (bf16*)(ws + WS_HP);
    float* PM = (float*)(ws + WS_PM);
    const int lo = a.ph_lo, hi = a.ph_hi;
    cg::grid_group grid = cg::this_grid();
    volatile LAS unsigned* bst = (volatile LAS unsigned*)(lds + LDS_CTL);
    if (tid < 2) bst[tid] = 0u;
    __syncthreads();
    unsigned* barw = (unsigned*)(ws + WS_BAR);
    XcdBarrier xb = xcd_barrier_post(barw, bst);
    if (lo == -2) grid.sync();
#define IN(k) (lo <= (k) && (k) < hi)
#define SEAM(k) do { if (IN(k) && IN((k) + 1)) xcd_barrier(xb); } while (0)

    if (IN(0)) {
#if !NAIVE_S5
        if (gw & 1) for (int it = gw; it < NG * ST; it += NGW) s5_table_item(lds, a, MLAG, WST, WC, it, wave, lane);
#endif
        LAS float* scr = (LAS float*)(lds + wave * 18432);
        constexpr int I_IN = 32 * 64, I_GLU = 16 * 16, I_OUT = 32 * 32, I_G = 32 * 88, I_D = 88 * 32;
        constexpr int NITEMS = I_IN + I_GLU + I_OUT + 2 * I_G + I_D;
        for (int it = gw; it < NITEMS; it += NGW) {
            int r = it;
            if (r < I_IN) { conv_item(a.in[2], 2048, 4096, WIN, a.in[1], 1, scr, r, lane); continue; } r -= I_IN;
            if (r < I_GLU) { conv_item(a.in[11], 1024, 1024, WGLU, nullptr, 0, scr, r, lane); continue; } r -= I_GLU;
            if (r < I_OUT) { conv_item(a.in[13], 2048, 2048, WOUT, nullptr, 0, scr, r, lane); continue; } r -= I_OUT;
            if (r < I_G) { conv_item(a.in[15], 2048, DFF, WGU, a.in[14], 2, scr, r, lane); continue; } r -= I_G;
            if (r < I_G) { conv_item(a.in[16], 2048, DFF, WGU, a.in[14], 3, scr, r, lane); continue; } r -= I_G;
            conv_item(a.in[17], DFF, 2048, WDN, nullptr, 0, scr, r, lane);
        }
#if !NAIVE_S5
        if (!(gw & 1)) for (int it = gw; it < NG * ST; it += NGW) s5_table_item(lds, a, MLAG, WST, WC, it, wave, lane);
#endif
        for (int idx = gw * 64 + lane; idx < S * 16; idx += NGW * 64) {
            const int pos = idx >> 4, i = idx & 15;
            const float invf = powf(500000.f, -(float)i * (1.f / 16.f));
            const float ang = (float)pos * invf;
            RC[idx] = cosf(ang); RS[idx] = sinf(ang);
        }
        const float* x = a.in[0];
        for (int row = gw; row < S; row += 2 * NGW) {
            const int row2 = row + NGW;
            const bool has2 = row2 < S;
            const f32x4* xr = (const f32x4*)(x + (size_t)row * 2048) + lane; const f32x4* xr2 = (const f32x4*)(x + (size_t)(has2 ? row2 : row) * 2048) + lane;
            f32x4 v[8], v2[8]; float s = 0.f, s2 = 0.f;
#pragma unroll
            for (int j = 0; j < 8; ++j) { v[j] = __builtin_nontemporal_load(xr + 64 * j); v2[j] = __builtin_nontemporal_load(xr2 + 64 * j); }
#pragma unroll
            for (int j = 0; j < 8; ++j) { s += (v[j][0] * v[j][0] + v[j][1] * v[j][1]) + (v[j][2] * v[j][2] + v[j][3] * v[j][3]); s2 += (v2[j][0] * v2[j][0] + v2[j][1] * v2[j][1]) + (v2[j][2] * v2[j][2] + v2[j][3] * v2[j][3]); }
            s = wave_sum(s); s2 = wave_sum(s2);
            u32x2* o8 = (u32x2*)(XB + (size_t)row * 2048) + lane;
#pragma unroll
            for (int j = 0; j < 8; ++j) { u32x2 w; w.x = pk2(v[j][0], v[j][1]); w.y = pk2(v[j][2], v[j][3]); o8[64 * j] = w; }
            if (lane == 0) { R1[row] = rsqrtf(s * (1.f / 2048.f) + EPS); SS2[row] = 0.f; SS3[row] = 0.f; if (row < 64) { ((unsigned*)(ws + WS_CNT))[64 * row] = 0u; ((unsigned*)(ws + WS_CNT))[64 * 64 + 64 * row] = 0u; } }
            if (has2) {
                u32x2* o82 = (u32x2*)(XB + (size_t)row2 * 2048) + lane;
#pragma unroll
                for (int j = 0; j < 8; ++j) { u32x2 w; w.x = pk2(v2[j][0], v2[j][1]); w.y = pk2(v2[j][2], v2[j][3]); o82[64 * j] = w; }
                if (lane == 0) { R1[row2] = rsqrtf(s2 * (1.f / 2048.f) + EPS); SS2[row2] = 0.f; SS3[row2] = 0.f; }
            }
        }
    }
    SEAM(0);
    if (IN(1)) { F1 f{R1, RC, RS, Qb, Kb, Vb, Ub, nullptr}; gemm_run<F1>(lds, XB, WIN, S, INW, 2048, f, gw, NGW, lane); }
    SEAM(1);
    if (IN(2)) {
#if NAIVE_ATTN
        attn_naive(lds, Qb, Kb, Vb, CAT, gw, NGW, wave, lane);
#else
        attn_phase(lds, Qb, Kb, Vb, ws, PM, tid, wave, lane);
#endif
#if !NAIVE_S5
        for (int vb = blockIdx.x; vb < 256; vb += gridDim.x) s5_state_block(lds, WST, Ub, SC, vb, tid, wave, lane);
#endif
    }
    SEAM(2);
#if NAIVE_S5
    if (IN(3)) { if (gw < NG) s5_naive(lds, a, Ub, Yb, gw, wave, lane); }
    SEAM(3);
    SEAM(4);
#else
#ifndef MERGE_P34
#define MERGE_P34 1
#endif
#if MERGE_P34
    if (IN(3)) {
        unsigned* flg = (unsigned*)(ws + WS_CNT) + 64 * 64;
        const int G = (int)gridDim.x, b = (int)blockIdx.x;
        if (G == 256) {
            if (b < NG) {
                s5_scan_block(lds, a, SC, HP, b, wave, lane);
                asm volatile("s_waitcnt vmcnt(0)" ::: "memory");
                __syncthreads();
                if (tid == 0) { __builtin_amdgcn_fence(__ATOMIC_RELEASE, "agent"); asm volatile("s_waitcnt vmcnt(0)" ::: "memory"); __hip_atomic_store(flg + 64 * b, 1u, __ATOMIC_RELAXED, __HIP_MEMORY_SCOPE_AGENT); }
            }
            const long NIT = (long)S * 128, W = 192 * 5 + 64 * 3;
            const long c0 = b <= NG ? 3L * b : 192L + 5L * (b - NG), c1 = (b + 1) <= NG ? 3L * (b + 1) : 192L + 5L * (b + 1 - NG);
            const int i0 = (int)(NIT * c0 / W), i1 = (int)(NIT * c1 / W);
            attn_combine(ws, PM, CAT, i0 + tid, 512, i1);
            const int g = b >> 2;
            if (tid == 0) { unsigned sp = 0; while (__hip_atomic_load(flg + 64 * g, __ATOMIC_RELAXED, __HIP_MEMORY_SCOPE_AGENT) == 0u) { __builtin_amdgcn_s_sleep(4); if (++sp > (1u << 22)) break; }
                __builtin_amdgcn_fence(__ATOMIC_ACQUIRE, "agent"); asm volatile("s_waitcnt vmcnt(0)" ::: "memory"); }
            __syncthreads();
            s5_out_block2(lds, MLAG, WC, HP, Ub, a.in[10], Yb, b, tid, wave, lane);
        } else {
            for (int g = blockIdx.x; g < NG; g += gridDim.x) s5_scan_block(lds, a, SC, HP, g, wave, lane);
            attn_combine(ws, PM, CAT, blockIdx.x * 512 + tid, gridDim.x * 512);
            xcd_barrier(xb);
            for (int vb = blockIdx.x; vb < 256; vb += gridDim.x) s5_out_block2(lds, MLAG, WC, HP, Ub, a.in[10], Yb, vb, tid, wave, lane);
        }
    }
    if (IN(3) && !IN(4)) { }
    if (IN(4) && IN(5)) xcd_barrier(xb);
#else
    if (IN(3)) {
        for (int g = blockIdx.x; g < NG; g += gridDim.x) s5_scan_block(lds, a, SC, HP, g, wave, lane);
#if !NAIVE_ATTN
        attn_combine(ws, PM, CAT, blockIdx.x * 512 + tid, gridDim.x * 512);
#endif
    }
    SEAM(3);
    if (IN(4)) { for (int vb = blockIdx.x; vb < 256; vb += gridDim.x) s5_out_block2(lds, MLAG, WC, HP, Ub, a.in[10], Yb, vb, tid, wave, lane); }
    SEAM(4);
#endif
#endif
    if (IN(5)) { F2 f{Yb, a.in[12], CAT, nullptr}; gemm_run<F2>(lds, Yb, WGLU, S, 1024, 1024, f, gw, NGW, lane); }
    SEAM(5);
    if (IN(6)) { F3 f{a.in[0], a.out, XB, SS2}; gemm_run<F3>(lds, CAT, WOUT, S, 2048, 2048, f, gw, NGW, lane); }
    SEAM(6);
#if USE_PG8
    if (IN(7)) { pg8::Gemm g{XB, WGU, S, 2 * DFF, 2048}; pg8::StaticOrder So; So.init(S, 2 * DFF, (int)gridDim.x, (int)blockIdx.x); EpiSwiGLU E{SS2, HH};
        pg8::gemm_phase<EpiSwiGLU, pg8::StaticOrder, true, true>(lds, g, So, E); }
#else
    if (IN(7)) { F4 f{SS2, HH, nullptr}; gemm_run<F4>(lds, XB, WGU, S, 2 * DFF, 2048, f, gw, NGW, lane); }
#endif
    SEAM(7);
#if FUSE_NORM && USE_PG8
    if (IN(8)) {
        pg8::Gemm g{HH, WDN, S, 2048, DFF}; PanelOrder So; So.init(S, 2048, (int)gridDim.x, (int)blockIdx.x);
        EpiDownNorm E{a.out, XB, a.out, SS3, (unsigned*)(ws + WS_CNT), a.in[18]};
        pg8::gemm_phase<EpiDownNorm, PanelOrder, true, true>(lds, g, So, E);
    }
#else
    if (IN(8)) { F5 f{a.out, SS3}; gemm_run<F5>(lds, HH, WDN, S, 2048, DFF, f, gw, NGW, lane); }
#endif
    SEAM(8);
    if (IN(9)) {
        const float* fg = a.in[18];
        for (int row = gw; row < S; row += NGW) {
            const float r = rsqrtf(SS3[row] * (1.f / 2048.f) + EPS);
            f32x4* orow = (f32x4*)(a.out + (size_t)row * 2048) + lane;
#pragma unroll
            for (int j = 0; j < 8; ++j) { const f32x4 g = ((const f32x4*)fg)[64 * j + lane]; f32x4 v = orow[64 * j]; v = v * r * g; orow[64 * j] = v; }
        }
    }
#ifdef PROBE_CUTS
    if (IN(10)) { F0 f{SS3 + 20000, nullptr}; gemm_run<F0>(lds, XB, WGU, S, 2 * DFF, 2048, f, gw, NGW, lane); }
#endif
#undef IN
#undef SEAM
}

extern "C" void kernel_launch(void* const* d_in, const int* in_sizes, int n_in, void* d_out, int out_size, void* d_ws, size_t ws_size, hipStream_t stream) {
    static int grid = 0;
    if (grid == 0) {
        if (n_in != 19 || ws_size < WS_END3) { fprintf(stderr, "kernel_launch: unexpected n_in %d / ws %zu\n", n_in, ws_size); grid = -1; return; }
        int dev = 0, cus = 0, per_cu = 0;
        (void)hipGetDevice(&dev);
        (void)hipDeviceGetAttribute(&cus, hipDeviceAttributeMultiprocessorCount, dev);
        (void)hipFuncSetAttribute((const void*)mega, hipFuncAttributeMaxDynamicSharedMemorySize, LDS_BYTES);
        (void)hipOccupancyMaxActiveBlocksPerMultiprocessor(&per_cu, (const void*)mega, 512, LDS_BYTES);
        if (per_cu < 1) per_cu = 1;
        grid = cus * per_cu;
        (void)hipGetLastError();
    }
    if (grid < 0) return;
    Args a{};
    for (int i = 0; i < 19; ++i) a.in[i] = (const float*)d_in[i];
    a.out = (float*)d_out; a.ws = (unsigned char*)d_ws;
#if N_LAUNCH_MODE == 1
    for (int ph = 0; ph < NPHASE; ++ph) {
        if (ph == 4 && NAIVE_S5) continue;
        a.ph_lo = ph; a.ph_hi = ph + 1;
        hipLaunchKernelGGL(mega, dim3(grid), dim3(512), LDS_BYTES, stream, a);
    }
#else
#ifdef PROBE_CUTS
    const int cuts[][2] = PROBE_CUTS;
    const int nl = (int)(sizeof(cuts) / sizeof(cuts[0]));
#elif defined(PROBE_SPLIT)
    const int cuts[2][2] = {{0, PROBE_SPLIT + 1}, {PROBE_SPLIT + PROBE_DUP - 1, NPHASE}};
    const int nl = 2;
#else
    const int cuts[1][2] = {{0, NPHASE}};
    const int nl = 1;
#endif
    for (int li = 0; li < nl; ++li) {
        (void)hipMemsetAsync((unsigned char*)d_ws + WS_BAR, 0, XCD_BAR_WORDS * 4, stream);
        a.ph_lo = cuts[li][0]; a.ph_hi = cuts[li][1];
        void* args[] = {&a};
        hipError_t e = hipLaunchCooperativeKernel((const void*)mega, dim3(grid), dim3(512), args, LDS_BYTES, stream);
        if (e != hipSuccess) fprintf(stderr, "cooperative launch failed: %s (grid %d)\n", hipGetErrorString(e), grid);
    }
#endif
}
```

```cpp
#include <hip/hip_runtime.h>
#include <hip/hip_cooperative_groups.h>
#include <cstdio>
#include <cstdint>
#include <cmath>
namespace cg = cooperative_groups;
#define N_LAUNCH_MODE 0
#define USE_PG8 1
#define NAIVE_S5 0
#define NAIVE_ATTN 0
namespace pg8 {
#define PG8_LAS __attribute__((address_space(3)))
typedef unsigned short bf16_t;
typedef short bf16x8 __attribute__((ext_vector_type(8)));
typedef float f32x4 __attribute__((ext_vector_type(4)));
typedef unsigned u32x4 __attribute__((ext_vector_type(4)));
constexpr int BM = 256, BK = 64, HALF = 128, HTB = HALF * BK * 2  , STAGE_BYTES = 8 * HTB, NXCD = 8, WGM = 8;

__host__ __device__ __forceinline__ int lds_byte(int r, int c) { const int st = (r >> 4) * 2 + (c >> 5), rr = r & 15, cc = c & 31, ob = rr * 64 + cc * 2; return st * 1024 + (ob ^ (((ob >> 9) & 1) << 5)); }
__host__ __device__ __forceinline__ void stage_rc(int b, int& R, int& C) { const int st = b / 1024, sb = b % 1024, swz = sb ^ (((sb >> 9) & 1) << 5); R = (st >> 1) * 16 + swz / 64; C = (st & 1) * 32 + (swz % 64) / 2; }
__host__ __device__ __forceinline__ int perm32(int rho) { const int n = rho >> 4, i = rho & 15; return 8 * (i >> 2) + 4 * n + (i & 3); }

struct Unit { int pm, pn; };
struct Gemm { const bf16_t* A; const bf16_t* Bt; int M, N, K; };

struct StaticOrder {
    int nM, nN, nwg, G, c;
    __host__ __device__ void init(int M, int N, int G_, int c_) { nM = M / BM; nN = N / BM; nwg = nM * nN; G = G_; c = c_; }
    __host__ __device__ bool next(int i, Unit& u) const {
        const long L = (long)i * G + c; if (L >= nwg) return false;
        int wgid = (int)L; { const int q = nwg / NXCD, r = nwg % NXCD, xcd = wgid % NXCD, off = wgid / NXCD; wgid = (xcd < r ? xcd * (q + 1) : r * (q + 1) + (xcd - r) * q) + off; }
        const int nig = WGM * nN, gid = wgid / nig, fm = gid * WGM, gsz = (nM - fm) < WGM ? (nM - fm) : WGM;
        u.pm = fm + ((wgid % nig) % gsz); u.pn = (wgid % nig) / gsz; return true;
    }
    __device__ __forceinline__ void a_ready(const Unit&) const {}
    __device__ __forceinline__ void done(const Unit&) const {}
};

__device__ __forceinline__ unsigned cvt_pk_bf16(float lo, float hi) { unsigned r; asm volatile("v_cvt_pk_bf16_f32 %0, %1, %2" : "=v"(r) : "v"(lo), "v"(hi)); return r; }
template <class Epi, class Sched, bool ALIGN_EPI = false, bool SP2 = false>
__device__ __forceinline__ void gemm_phase(PG8_LAS unsigned char* lds, const Gemm g, const Sched& S, const Epi& E) {
    const int tid = threadIdx.x, wid = __builtin_amdgcn_readfirstlane(tid >> 6), lane = tid & 63, wr = wid >> 2, wc = wid & 3, fr = lane & 15, fq = lane >> 4;
    const int K = g.K, nt = K / BK;
    unsigned voffA[2], voffB[2];
#pragma unroll
    for (int i = 0; i < 2; ++i) { int R, C; stage_rc(tid * 16 + i * 8192, R, C); const int Rb = Epi::PERM ? ((R & ~31) + perm32(R & 31)) : R;
        voffA[i] = (unsigned)(R * K + C) * 2u; voffB[i] = (unsigned)(Rb * K + C) * 2u; }
    const size_t kstep = (size_t)(BK * 2);
    const size_t hstep = (size_t)HALF * K * 2;
    const size_t tstep = 2 * hstep;
    const unsigned ldsw = (unsigned)wid * 1024u;
    const int aoff = lds_byte(wr * 64 + fr, fq * 8), boff = lds_byte(wc * 32 + fr, fq * 8);
#define PG8_SA(b, h) (((b) * 2 + (h)) * HTB)
#define PG8_SB(b, h) ((4 + (b) * 2 + (h)) * HTB)
#define PG8_STAGE(bufoff, gbase, voff) do { _Pragma("unroll") for (int _i = 0; _i < 2; ++_i) \
        __builtin_amdgcn_global_load_lds((const unsigned*)((const char*)(gbase) + (voff)[_i]), (PG8_LAS unsigned*)(lds + (bufoff) + ldsw + _i * 8192), 16, 0, 0); } while (0)
#define PG8_LDA(dst, b, h) do { _Pragma("unroll") for (int m = 0; m < 4; ++m) _Pragma("unroll") for (int k = 0; k < 2; ++k) dst[m][k] = *(const PG8_LAS bf16x8*)(lds + PG8_SA(b, h) + aoff + m * 2048 + k * 1024); } while (0)
#define PG8_LDB(dst, b, h) do { _Pragma("unroll") for (int n = 0; n < 2; ++n) _Pragma("unroll") for (int k = 0; k < 2; ++k) dst[n][k] = *(const PG8_LAS bf16x8*)(lds + PG8_SB(b, h) + boff + n * 2048 + k * 1024); } while (0)
#define PG8_MMA(ai, bj, At, Bt) do { __builtin_amdgcn_s_setprio(1); _Pragma("unroll") for (int m = 0; m < 4; ++m) _Pragma("unroll") for (int n = 0; n < 2; ++n) _Pragma("unroll") for (int k = 0; k < 2; ++k) \
        acc[ai][bj][m][n] = __builtin_amdgcn_mfma_f32_16x16x32_bf16(Bt[n][k], At[m][k], acc[ai][bj][m][n], 0, 0, 0); __builtin_amdgcn_s_setprio(0); } while (0)
#define PG8_WAIT_V(n) asm volatile("s_waitcnt vmcnt(" #n ")" ::: "memory")
#define PG8_WAIT_L(n) asm volatile("s_waitcnt lgkmcnt(" #n ")" ::: "memory")
#define PG8_BAR __builtin_amdgcn_s_barrier()
#define PG8_SCHED __builtin_amdgcn_sched_barrier(0)
    Unit cur, nxt; int ui = 0;
    if (!S.next(0, cur)) return;
    f32x4 acc[2][2][4][2];
#pragma unroll
    for (int a = 0; a < 2; ++a)
#pragma unroll
        for (int b = 0; b < 2; ++b)
#pragma unroll
            for (int m = 0; m < 4; ++m)
#pragma unroll
                for (int n = 0; n < 2; ++n) acc[a][b][m][n] = (f32x4){0.f, 0.f, 0.f, 0.f};
    bf16x8 At[4][2], B0[2][2], B1[2][2];
    const char* cA = (const char*)g.A + (size_t)cur.pm * tstep; const char* cB = (const char*)g.Bt + (size_t)cur.pn * tstep;
    S.a_ready(cur);
    if constexpr (SP2) {
        PG8_STAGE(PG8_SB(0, 0), cB, voffB); PG8_STAGE(PG8_SB(0, 1), cB + hstep, voffB); PG8_STAGE(PG8_SA(0, 0), cA, voffA); PG8_STAGE(PG8_SA(0, 1), cA + hstep, voffA);
        if (wr == 1) PG8_BAR;
        PG8_WAIT_V(2); PG8_BAR;
        PG8_STAGE(PG8_SB(1, 0), cB + kstep, voffB); PG8_STAGE(PG8_SA(1, 0), cA + kstep, voffA); PG8_STAGE(PG8_SB(1, 1), cB + hstep + kstep, voffB);
        PG8_WAIT_V(6); PG8_BAR;
    } else {
        PG8_STAGE(PG8_SB(0, 0), cB, voffB); PG8_STAGE(PG8_SA(0, 0), cA, voffA); PG8_STAGE(PG8_SB(0, 1), cB + hstep, voffB); PG8_STAGE(PG8_SA(0, 1), cA + hstep, voffA);
        if (wr == 1) PG8_BAR;
        PG8_WAIT_V(4); PG8_BAR;
        PG8_STAGE(PG8_SB(1, 0), cB + kstep, voffB); PG8_STAGE(PG8_SA(1, 0), cA + kstep, voffA); PG8_STAGE(PG8_SB(1, 1), cB + hstep + kstep, voffB);
        PG8_WAIT_V(6); PG8_BAR;
    }
    for (;;) {
        const bool has_next = S.next(ui + 1, nxt);
        const char* nA = has_next ? (const char*)g.A + (size_t)nxt.pm * tstep : cA; const char* nB = has_next ? (const char*)g.Bt + (size_t)nxt.pn * tstep : cB;
        for (int t = 0; t < nt; t += 2) {
            const bool last = (t == nt - 2);
            const char* a1 = cA + (size_t)(t + 1) * kstep;
            const char* a2 = last ? nA : cA + (size_t)(t + 2) * kstep; const char* b2 = last ? nB : cB + (size_t)(t + 2) * kstep;
            const char* a3 = a2 + kstep; const char* b3 = b2 + kstep;
            if (last && has_next) S.a_ready(nxt);
            if constexpr (SP2) {
            PG8_LDB(B0, 0, 0); PG8_LDB(B1, 0, 1); PG8_SCHED; PG8_LDA(At, 0, 0); PG8_STAGE(PG8_SA(1, 1), a1 + hstep, voffA);
            PG8_WAIT_V(8); PG8_WAIT_L(0); PG8_BAR; PG8_MMA(0, 0, At, B0); PG8_MMA(0, 1, At, B1); PG8_BAR; PG8_SCHED;
            PG8_LDA(At, 0, 1); PG8_STAGE(PG8_SB(0, 0), b2, voffB); PG8_STAGE(PG8_SB(0, 1), b2 + hstep, voffB); PG8_STAGE(PG8_SA(0, 0), a2, voffA);
            PG8_WAIT_V(8); PG8_WAIT_L(0); PG8_BAR; PG8_MMA(1, 0, At, B0); PG8_MMA(1, 1, At, B1); PG8_BAR; PG8_SCHED;
            PG8_LDB(B0, 1, 0); PG8_LDB(B1, 1, 1); PG8_SCHED; PG8_LDA(At, 1, 0); PG8_STAGE(PG8_SA(0, 1), a2 + hstep, voffA);
            PG8_WAIT_V(8); PG8_WAIT_L(0); PG8_BAR; PG8_MMA(0, 0, At, B0); PG8_MMA(0, 1, At, B1); PG8_BAR; PG8_SCHED;
            PG8_LDA(At, 1, 1); PG8_STAGE(PG8_SB(1, 0), b3, voffB); PG8_STAGE(PG8_SB(1, 1), b3 + hstep, voffB); PG8_STAGE(PG8_SA(1, 0), a3, voffA);
            PG8_WAIT_V(8); PG8_WAIT_L(0); PG8_BAR; PG8_MMA(1, 0, At, B0); PG8_MMA(1, 1, At, B1); PG8_BAR; PG8_SCHED;
            } else {
            PG8_LDB(B0, 0, 0); PG8_SCHED; PG8_LDA(At, 0, 0); PG8_STAGE(PG8_SA(1, 1), a1 + hstep, voffA);
            PG8_WAIT_L(8); PG8_BAR; PG8_WAIT_L(0); PG8_MMA(0, 0, At, B0); PG8_BAR; PG8_SCHED;
            PG8_LDB(B1, 0, 1); PG8_STAGE(PG8_SB(0, 0), b2, voffB);
            PG8_BAR; PG8_WAIT_L(0); PG8_MMA(0, 1, At, B1); PG8_BAR;
            PG8_LDA(At, 0, 1); PG8_STAGE(PG8_SA(0, 0), a2, voffA);
            PG8_BAR; PG8_WAIT_L(0); PG8_MMA(1, 0, At, B0); PG8_BAR; PG8_SCHED;
            PG8_STAGE(PG8_SB(0, 1), b2 + hstep, voffB);
            PG8_WAIT_V(6); PG8_BAR; PG8_MMA(1, 1, At, B1); PG8_BAR;
            PG8_LDB(B0, 1, 0); PG8_SCHED; PG8_LDA(At, 1, 0); PG8_STAGE(PG8_SA(0, 1), a2 + hstep, voffA);
            PG8_WAIT_L(8); PG8_BAR; PG8_WAIT_L(0); PG8_MMA(0, 0, At, B0); PG8_BAR; PG8_SCHED;
            PG8_LDB(B1, 1, 1); PG8_STAGE(PG8_SB(1, 0), b3, voffB);
            PG8_BAR; PG8_WAIT_L(0); PG8_MMA(0, 1, At, B1); PG8_BAR;
            PG8_LDA(At, 1, 1); PG8_STAGE(PG8_SA(1, 0), a3, voffA);
            PG8_BAR; PG8_WAIT_L(0); PG8_MMA(1, 0, At, B0); PG8_BAR; PG8_SCHED;
            PG8_STAGE(PG8_SB(1, 1), b3 + hstep, voffB);
            PG8_WAIT_V(6); PG8_BAR; PG8_MMA(1, 1, At, B1); PG8_BAR;
            }
        }
        if constexpr (ALIGN_EPI) { if (wr == 0) PG8_BAR; }
        if constexpr (!Epi::AFTER_DRAIN) { E(acc, cur, wr, wc, fr, fq); S.done(cur); }
        if (!has_next) break;
#pragma unroll
        for (int a = 0; a < 2; ++a)
#pragma unroll
            for (int b = 0; b < 2; ++b)
#pragma unroll
                for (int m = 0; m < 4; ++m)
#pragma unroll
                    for (int n = 0; n < 2; ++n) acc[a][b][m][n] = (f32x4){0.f, 0.f, 0.f, 0.f};
        cur = nxt; cA = nA; cB = nB; ++ui;
        if constexpr (ALIGN_EPI) { if (wr == 1) PG8_BAR; }
    }
    PG8_WAIT_V(0);
    if constexpr (!ALIGN_EPI) { if (wr == 0) PG8_BAR; }
    PG8_BAR;
    if constexpr (Epi::AFTER_DRAIN) { E.fused(acc, cur, wr, wc, fr, fq, lds, wid, lane); S.done(cur); }
#undef PG8_SA
#undef PG8_SB
#undef PG8_STAGE
#undef PG8_LDA
#undef PG8_LDB
#undef PG8_MMA
#undef PG8_WAIT_V
#undef PG8_WAIT_L
#undef PG8_BAR
#undef PG8_SCHED
}
}

struct Args { const float* in[19]; float* out; unsigned char* ws; int ph_lo, ph_hi; };

#define LAS __attribute__((address_space(3)))
typedef unsigned short bf16;
typedef short bf16x8 __attribute__((ext_vector_type(8)));
typedef float f32x4 __attribute__((ext_vector_type(4)));
typedef float f32x16 __attribute__((ext_vector_type(16)));
typedef unsigned u32x4 __attribute__((ext_vector_type(4)));
typedef unsigned u32x2 __attribute__((ext_vector_type(2)));

#ifndef N_LAUNCH_MODE
#define N_LAUNCH_MODE 0
#endif
#ifndef USE_PG8
#define USE_PG8 1
#endif
#ifndef NAIVE_ATTN
#define NAIVE_ATTN 1
#endif
#ifndef NAIVE_S5
#define NAIVE_S5 1
#endif

constexpr int S = 16384, DM = 2048, AW = 1024, HD = 128, NH = 8, DFF = 5632, INW = 4096;
constexpr int NG = 64;
constexpr float EPS = 1e-6f;
constexpr float QSCALE = 0.08838834764831845f * 1.4426950408889634f;
#ifndef H1_BF16
#define H1_BF16 1
#endif
#ifndef FUSE_NORM
#define FUSE_NORM 1
#endif
constexpr int NPHASE = FUSE_NORM ? 9 : 10;

constexpr size_t MiB = 1u << 20;
constexpr size_t WS_SS2 = 0, WS_SS3 = 65536, WS_R1 = 131072, WS_ROPEC = 1 * MiB, WS_ROPES = 2 * MiB;
constexpr size_t WS_WIN = 16 * MiB, WS_WGLU = 32 * MiB, WS_WOUT = 34 * MiB, WS_WGU = 42 * MiB, WS_WDN = 86 * MiB;
constexpr size_t WS_XB = 108 * MiB;
constexpr size_t WS_Q = 172 * MiB, WS_K = 204 * MiB, WS_V = 236 * MiB, WS_U = 268 * MiB, WS_Y = 300 * MiB, WS_CAT = 332 * MiB;
constexpr size_t WS_HH = 172 * MiB;
constexpr size_t WS_END = 396 * MiB;
constexpr int LDS_BYTES = 147456 + 64, LDS_CTL = 147456;
constexpr size_t WS_BAR = 8 * MiB;

__device__ __forceinline__ unsigned f2bf(float f) { unsigned u = __builtin_bit_cast(unsigned, f); return (u + 0x7fffu + ((u >> 16) & 1u)) >> 16; }
typedef float f32x2_t __attribute__((ext_vector_type(2))); typedef __bf16 bf16x2_t __attribute__((ext_vector_type(2)));
__device__ __forceinline__ unsigned pk2(float lo, float hi) { f32x2_t v = {lo, hi}; bf16x2_t b = __builtin_convertvector(v, bf16x2_t); return __builtin_bit_cast(unsigned, b); }
__device__ __forceinline__ float bflo(unsigned w) { return __uint_as_float(w << 16); }
__device__ __forceinline__ float bfhi(unsigned w) { return __uint_as_float(w & 0xffff0000u); }
__device__ __forceinline__ float bf2f(bf16 b) { return __uint_as_float((unsigned)b << 16); }
__device__ __forceinline__ float wave_sum(float v) {
#pragma unroll
    for (int o = 1; o < 64; o <<= 1) v += __shfl_xor(v, o);
    return v;
}
__device__ __forceinline__ float wave_max(float v) {
#pragma unroll
    for (int o = 1; o < 64; o <<= 1) v = fmaxf(v, __shfl_xor(v, o));
    return v;
}
#define LBAR() do { asm volatile("s_waitcnt lgkmcnt(0)" ::: "memory"); __builtin_amdgcn_s_barrier(); asm volatile("" ::: "memory"); } while (0)
#define WSYNC() do { asm volatile("s_waitcnt lgkmcnt(0)" ::: "memory"); __builtin_amdgcn_wave_barrier(); } while (0)

__device__ __forceinline__ float gelu_tanh(float x) {
    const float t = 0.7978845608028654f * (x + 0.044715f * x * x * x);
    const float e = __expf(2.f * t);
    const float th = 1.f - 2.f * __builtin_amdgcn_rcpf(e + 1.f);
    return 0.5f * x * (1.f + th);
}
__device__ __forceinline__ float sigmoidf_(float z) { return __builtin_amdgcn_rcpf(1.f + __expf(-z)); }

__device__ __forceinline__ int rowmap(int mode, int n) {
    if (mode == 1) {
        if (n < 2048 && (n & 127) < 32) { const int d = n & 31; const int c = (d < 16) ? (8 * (d >> 2) + (d & 3)) : (8 * ((d - 16) >> 2) + 4 + (d & 3)); return (n & ~31) + c; }
        return n;
    }
    if (mode == 2 || mode == 3) { const int q = n >> 2, ch = (q & ~3) + (((q & 1) << 1) | ((q >> 1) & 1)); return 8 * ch + (mode == 3 ? 4 : 0) + (n & 3); }
    return n;
}
__device__ __forceinline__ void conv_item(const float* __restrict__ W, int K, int N, bf16* WT, const float* __restrict__ g, int mode, LAS float* scr, int item, int lane) {
    const int nblk = N / 64, kb = item / nblk, nb = item % nblk, k0 = 64 * kb, n0 = 64 * nb;
    f32x4 v[16];
#pragma unroll
    for (int i = 0; i < 16; ++i) v[i] = __builtin_nontemporal_load((const f32x4*)(W + (size_t)(k0 + 4 * i + (lane >> 4)) * N + n0 + 4 * (lane & 15)));
#pragma unroll
    for (int i = 0; i < 16; ++i) { const int kk = 4 * i + (lane >> 4); const float sc = g ? g[k0 + kk] : 1.f; LAS float* d = scr + kk * 65 + 4 * (lane & 15);
        d[0] = v[i][0] * sc; d[1] = v[i][1] * sc; d[2] = v[i][2] * sc; d[3] = v[i][3] * sc; }
    WSYNC();
    const int c = lane & 7;
#pragma unroll
    for (int j = 0; j < 8; ++j) { const int n = (lane >> 3) + 8 * j; const LAS float* s = scr + (8 * c) * 65 + n;
        u32x4 o; o.x = pk2(s[0 * 65], s[1 * 65]); o.y = pk2(s[2 * 65], s[3 * 65]); o.z = pk2(s[4 * 65], s[5 * 65]); o.w = pk2(s[6 * 65], s[7 * 65]);
        *(u32x4*)(WT + (size_t)rowmap(mode, n0 + n) * K + k0 + 8 * c) = o; }
    WSYNC();
}

struct F1 {
    static constexpr bool HAS_SS = false;
    struct Pre { float r; f32x4 cs, sn; };
    const float* r1; const float* rc; const float* rs; bf16 *Q, *K, *V, *U; float* ss;
    __device__ __forceinline__ void load(int row, int col, Pre& p) const {
        p.r = r1[row];
        const int reg = col >> 10, c = col & 1023;
        if (reg < 2 && (c & 127) < 32) { const int a = (c & 31) >> 3; p.cs = *(const f32x4*)(rc + (size_t)row * 16 + 4 * a); p.sn = *(const f32x4*)(rs + (size_t)row * 16 + 4 * a); }
    }
    __device__ __forceinline__ float apply(int row, int col, float (&v)[8], const Pre& p) const {
        const float r = p.r;
#pragma unroll
        for (int i = 0; i < 8; ++i) v[i] *= r;
        const int reg = col >> 10, c = col & 1023;
        bf16* dst;
        if (reg < 2) {
            if ((c & 127) < 32) {
#pragma unroll
                for (int i = 0; i < 4; ++i) { const float x1 = v[i], x2 = v[4 + i]; v[i] = x1 * p.cs[i] - x2 * p.sn[i]; v[4 + i] = x2 * p.cs[i] + x1 * p.sn[i]; }
            }
            if (reg == 0) {
#pragma unroll
                for (int i = 0; i < 8; ++i) v[i] *= QSCALE;
            }
            dst = (reg == 0 ? Q : K) + (size_t)row * 1024 + c;
        } else if (reg == 2) dst = V + (size_t)row * 1024 + c;
        else dst = U + ((size_t)(c >> 4) * S + row) * 16 + (c & 15);
        u32x4 o; o.x = pk2(v[0], v[1]); o.y = pk2(v[2], v[3]); o.z = pk2(v[4], v[5]); o.w = pk2(v[6], v[7]);
        *(u32x4*)dst = o;
        return 0.f;
    }
};
struct F2 {
    static constexpr bool HAS_SS = false;
    struct Pre { u32x4 yw; f32x4 b0, b1; };
    const bf16* Y; const float* b; bf16* CAT; float* ss;
    __device__ __forceinline__ void load(int row, int col, Pre& p) const { p.yw = *(const u32x4*)(Y + (size_t)row * 1024 + col); p.b0 = *(const f32x4*)(b + col); p.b1 = *(const f32x4*)(b + col + 4); }
    __device__ __forceinline__ float apply(int row, int col, float (&v)[8], const Pre& p) const {
        const u32x4 yw = p.yw;
        float y[8] = {bflo(yw.x), bfhi(yw.x), bflo(yw.y), bfhi(yw.y), bflo(yw.z), bfhi(yw.z), bflo(yw.w), bfhi(yw.w)};
        float o[8];
#pragma unroll
        for (int i = 0; i < 8; ++i) { const float z = v[i] + (i < 4 ? p.b0[i] : p.b1[i - 4]); o[i] = y[i] * sigmoidf_(z); }
        u32x4 w; w.x = pk2(o[0], o[1]); w.y = pk2(o[2], o[3]); w.z = pk2(o[4], o[5]); w.w = pk2(o[6], o[7]);
        *(u32x4*)(CAT + (size_t)row * 2048 + 1024 + col) = w;
        return 0.f;
    }
};
struct F3 {
    static constexpr bool HAS_SS = true;
    struct Pre { f32x4 x0, x1; };
    const float* x; float* H1; bf16* HB; float* ss;
#ifndef XRES_BF16
#define XRES_BF16 1
#endif
    __device__ __forceinline__ void load(int row, int col, Pre& p) const { const size_t off = (size_t)row * 2048 + col;
#if XRES_BF16
        const u32x4 w = *(const u32x4*)(HB + off);
        p.x0 = (f32x4){bflo(w.x), bfhi(w.x), bflo(w.y), bfhi(w.y)}; p.x1 = (f32x4){bflo(w.z), bfhi(w.z), bflo(w.w), bfhi(w.w)};
#else
        p.x0 = __builtin_nontemporal_load((const f32x4*)(x + off)); p.x1 = __builtin_nontemporal_load((const f32x4*)(x + off + 4));
#endif
    }
    __device__ __forceinline__ float apply(int row, int col, float (&v)[8], const Pre& p) const {
        const size_t off = (size_t)row * 2048 + col;
        f32x4 h0, h1; float s = 0.f;
#pragma unroll
        for (int i = 0; i < 4; ++i) { h0[i] = p.x0[i] + v[i]; h1[i] = p.x1[i] + v[4 + i]; s += h0[i] * h0[i] + h1[i] * h1[i]; }
#if !H1_BF16
        *(f32x4*)(H1 + off) = h0; *(f32x4*)(H1 + off + 4) = h1;
#endif
        u32x4 w; w.x = pk2(h0[0], h0[1]); w.y = pk2(h0[2], h0[3]); w.z = pk2(h1[0], h1[1]); w.w = pk2(h1[2], h1[3]);
        *(u32x4*)(HB + off) = w;
        return s;
    }
};
struct F4 {
    static constexpr bool HAS_SS = false;
    struct Pre { float s; };
    const float* ss2; bf16* HH; float* ss;
    __device__ __forceinline__ void load(int row, int col, Pre& p) const { p.s = ss2[row]; }
    __device__ __forceinline__ float apply(int row, int col, float (&v)[8], const Pre& p) const {
        const float r = rsqrtf(p.s * (1.f / 2048.f) + EPS);
        float o[4];
#pragma unroll
        for (int i = 0; i < 4; ++i) { const float g = v[i] * r, u = v[4 + i] * r; o[i] = g * sigmoidf_(g) * u; }
        u32x2 w; w.x = pk2(o[0], o[1]); w.y = pk2(o[2], o[3]);
        { const int ch = col >> 3, hc = 4 * ((ch & ~3) + (((ch & 1) << 1) | ((ch >> 1) & 1))); *(u32x2*)(HH + (size_t)row * DFF + hc) = w; }
        return 0.f;
    }
};
struct F5 {
    static constexpr bool HAS_SS = true;
    struct Pre { f32x4 h0, h1; };
    float* H; float* ss;
    __device__ __forceinline__ void load(int row, int col, Pre& p) const { const size_t off = (size_t)row * 2048 + col; p.h0 = *(const f32x4*)(H + off); p.h1 = *(const f32x4*)(H + off + 4); }
    __device__ __forceinline__ float apply(int row, int col, float (&v)[8], const Pre& p) const {
        const size_t off = (size_t)row * 2048 + col;
        f32x4 h0 = p.h0, h1 = p.h1; float s = 0.f;
#pragma unroll
        for (int i = 0; i < 4; ++i) { h0[i] += v[i]; h1[i] += v[4 + i]; s += h0[i] * h0[i] + h1[i] * h1[i]; }
        *(f32x4*)(H + off) = h0; *(f32x4*)(H + off + 4) = h1;
        return s;
    }
};

struct F0 {
    static constexpr bool HAS_SS = false;
    struct Pre { float s; };
    float* sink; float* ss;
    __device__ __forceinline__ void load(int, int, Pre& p) const { p.s = 0.f; }
    __device__ __forceinline__ float apply(int row, int col, float (&v)[8], const Pre&) const {
        const float t = (v[0] + v[1]) + (v[2] + v[3]) + (v[4] + v[5]) + (v[6] + v[7]);
        if (t == 1234567.125f) sink[0] = t;
        return 0.f;
    }
};

template <class F> struct EpiChunk {
    static constexpr bool PERM = true, AFTER_DRAIN = false;
    F f;
    __device__ __forceinline__ void operator()(const pg8::f32x4 (&acc)[2][2][4][2], const pg8::Unit& u, int wr, int wc, int fr, int fq) const {
        const int row0 = u.pm * 256 + wr * 64 + fr, col0 = u.pn * 256 + wc * 32 + 8 * fq;
        typename F::Pre pa[2], pb[2];
        f.load(row0, col0, pa[0]); f.load(row0, col0 + 128, pa[1]);
#pragma unroll
        for (int g = 0; g < 8; ++g) {
            const int ai = g >> 2, m = g & 3, row = row0 + ai * 128 + m * 16;
            if (g < 7) { const int row2 = row0 + ((g + 1) >> 2) * 128 + ((g + 1) & 3) * 16;
                if (g & 1) { f.load(row2, col0, pa[0]); f.load(row2, col0 + 128, pa[1]); } else { f.load(row2, col0, pb[0]); f.load(row2, col0 + 128, pb[1]); } }
            float ss = 0.f;
#pragma unroll
            for (int bj = 0; bj < 2; ++bj) {
                float v[8] = {acc[ai][bj][m][0][0], acc[ai][bj][m][0][1], acc[ai][bj][m][0][2], acc[ai][bj][m][0][3], acc[ai][bj][m][1][0], acc[ai][bj][m][1][1], acc[ai][bj][m][1][2], acc[ai][bj][m][1][3]};
                ss += f.apply(row, col0 + bj * 128, v, (g & 1) ? pb[bj] : pa[bj]);
            }
            if (F::HAS_SS) { ss += __shfl_xor(ss, 16); ss += __shfl_xor(ss, 32); if (fq == 0) atomicAdd(f.ss + row, ss); }
        }
    }
};

struct EpiSwiGLU {
    static constexpr bool PERM = true, AFTER_DRAIN = false;
    const float* ss2; bf16* HH;
    __device__ __forceinline__ void operator()(const pg8::f32x4 (&acc)[2][2][4][2], const pg8::Unit& u, int wr, int wc, int fr, int fq) const {
        const int row0 = u.pm * 256 + wr * 64 + fr, col0 = u.pn * 256 + wc * 32 + 8 * fq;
        float rs[8];
#pragma unroll
        for (int g = 0; g < 8; ++g) rs[g] = ss2[row0 + (g >> 2) * 128 + (g & 3) * 16];
#pragma unroll
        for (int g = 0; g < 8; ++g) rs[g] = rsqrtf(rs[g] * (1.f / 2048.f) + EPS);
        const int sg = ((fq & 1) << 1) | (fq >> 1);
        const bool up = fq >= 2;
#pragma unroll
        for (int ai = 0; ai < 2; ++ai)
#pragma unroll
            for (int mp = 0; mp < 2; ++mp) {
                const int rowA = row0 + ai * 128 + (2 * mp) * 16, rowB = rowA + 16;
                const float rA = rs[ai * 4 + 2 * mp], rB = rs[ai * 4 + 2 * mp + 1];
                const float rA2 = rA * rA, rB2 = rB * rB, rAl = rA * -1.4426950408889634f, rBl = rB * -1.4426950408889634f;
#pragma unroll
                for (int bj = 0; bj < 2; ++bj) {
                    const int ch = (col0 + bj * 128) >> 3, hc = 4 * ((ch & ~3) + sg);
                    float oa[4], ob[4];
#pragma unroll
                    for (int i = 0; i < 4; ++i) {
                        const float ga = acc[ai][bj][2 * mp][0][i], ua = acc[ai][bj][2 * mp][1][i];
                        oa[i] = (ga * ua) * (rA2 * __builtin_amdgcn_rcpf(1.f + __builtin_amdgcn_exp2f(ga * rAl)));
                        const float gb = acc[ai][bj][2 * mp + 1][0][i], ub = acc[ai][bj][2 * mp + 1][1][i];
                        ob[i] = (gb * ub) * (rB2 * __builtin_amdgcn_rcpf(1.f + __builtin_amdgcn_exp2f(gb * rBl)));
                    }
                    unsigned ax = pk2(oa[0], oa[1]), ay = pk2(oa[2], oa[3]), bx = pk2(ob[0], ob[1]), by = pk2(ob[2], ob[3]);
                    { auto rx = __builtin_amdgcn_permlane32_swap(ax, bx, false, false); ax = rx[0]; bx = rx[1]; }
                    { auto ry = __builtin_amdgcn_permlane32_swap(ay, by, false, false); ay = ry[0]; by = ry[1]; }
                    u32x4 o = {ax, ay, bx, by};
                    *(u32x4*)(HH + (size_t)(up ? rowB : rowA) * DFF + (up ? hc - 4 : hc)) = o;
                }
            }
    }
};

constexpr size_t WS_CNT = 9 * MiB;
struct PanelOrder : pg8::StaticOrder {
    __device__ __forceinline__ bool next(int i, pg8::Unit& u) const { const long L = (long)i * G + c; if (L >= nwg) return false; const int xcd = (int)(L & 7), off = (int)(L >> 3); u.pm = xcd * 8 + (off >> 3); u.pn = off & 7; return true; }
};
struct EpiDownNorm {
    static constexpr bool PERM = true, AFTER_DRAIN = false;
    const float* H1; const bf16* HB; float* out; float* ss; unsigned* cnt; const float* fg;
    __device__ __forceinline__ void operator()(const pg8::f32x4 (&acc)[2][2][4][2], const pg8::Unit& u, int wr, int wc, int fr, int fq) const {
        const int row0 = u.pm * 256 + wr * 64 + fr, col0 = u.pn * 256 + wc * 32 + 8 * fq;
        f32x4 h[2][2][4][2];
#pragma unroll
        for (int ai = 0; ai < 2; ++ai)
#pragma unroll
            for (int bj = 0; bj < 2; ++bj)
#pragma unroll
                for (int m = 0; m < 4; ++m) { h[ai][bj][m][0] = acc[ai][bj][m][0]; h[ai][bj][m][1] = acc[ai][bj][m][1]; }
        f32x4 pa[2][2], pb[2][2];
#if H1_BF16
#define EDN_LOAD(P, row) do { const bf16* s_ = HB + (size_t)(row) * 2048 + col0; const u32x4 w0_ = *(const u32x4*)s_, w1_ = *(const u32x4*)(s_ + 128); \
        P[0][0] = (f32x4){bflo(w0_.x), bfhi(w0_.x), bflo(w0_.y), bfhi(w0_.y)}; P[0][1] = (f32x4){bflo(w0_.z), bfhi(w0_.z), bflo(w0_.w), bfhi(w0_.w)}; \
        P[1][0] = (f32x4){bflo(w1_.x), bfhi(w1_.x), bflo(w1_.y), bfhi(w1_.y)}; P[1][1] = (f32x4){bflo(w1_.z), bfhi(w1_.z), bflo(w1_.w), bfhi(w1_.w)}; } while (0)
#else
#define EDN_LOAD(P, row) do { const float* s_ = H1 + (size_t)(row) * 2048 + col0; P[0][0] = *(const f32x4*)s_; P[0][1] = *(const f32x4*)(s_ + 4); P[1][0] = *(const f32x4*)(s_ + 128); P[1][1] = *(const f32x4*)(s_ + 132); } while (0)
#endif
        EDN_LOAD(pa, row0);
#pragma unroll
        for (int g = 0; g < 8; ++g) {
            const int ai = g >> 2, m = g & 3, row = row0 + ai * 128 + m * 16;
            if (g < 7) { const int row2 = row0 + ((g + 1) >> 2) * 128 + ((g + 1) & 3) * 16; if (g & 1) EDN_LOAD(pa, row2); else EDN_LOAD(pb, row2); }
            float s = 0.f;
#pragma unroll
            for (int bj = 0; bj < 2; ++bj)
#pragma unroll
                for (int n = 0; n < 2; ++n) { const f32x4 hv = h[ai][bj][m][n] + ((g & 1) ? pb[bj][n] : pa[bj][n]); h[ai][bj][m][n] = hv; s += (hv[0] * hv[0] + hv[1] * hv[1]) + (hv[2] * hv[2] + hv[3] * hv[3]); }
            s += __shfl_xor(s, 16); s += __shfl_xor(s, 32);
            if (fq == 0) atomicAdd(ss + row, s);
        }
#undef EDN_LOAD
        asm volatile("s_waitcnt vmcnt(0)" ::: "memory");
        unsigned* cw = cnt + 64 * u.pm;
        if ((threadIdx.x & 63) == 0) __hip_atomic_fetch_add(cw, 1u, __ATOMIC_RELAXED, __HIP_MEMORY_SCOPE_AGENT);
        f32x4 gv[2][2];
#pragma unroll
        for (int bj = 0; bj < 2; ++bj) { gv[bj][0] = *(const f32x4*)(fg + col0 + bj * 128); gv[bj][1] = *(const f32x4*)(fg + col0 + bj * 128 + 4); }
        { unsigned spins = 0;
          while ((unsigned)__builtin_amdgcn_readfirstlane((int)__hip_atomic_load(cw, __ATOMIC_RELAXED, __HIP_MEMORY_SCOPE_AGENT)) < 64u) { __builtin_amdgcn_s_sleep(2); if (++spins > (1u << 20)) break; } }
        __builtin_amdgcn_fence(__ATOMIC_ACQUIRE, "agent");
        float tot[8];
#pragma unroll
        for (int g = 0; g < 8; ++g) tot[g] = __hip_atomic_load(ss + row0 + (g >> 2) * 128 + (g & 3) * 16, __ATOMIC_RELAXED, __HIP_MEMORY_SCOPE_AGENT);
#pragma unroll
        for (int g = 0; g < 8; ++g) {
            const int ai = g >> 2, m = g & 3, row = row0 + ai * 128 + m * 16;
            const float r = rsqrtf(tot[g] * (1.f / 2048.f) + EPS);
            float* o = out + (size_t)row * 2048 + col0;
#pragma unroll
            for (int bj = 0; bj < 2; ++bj)
#pragma unroll
                for (int n = 0; n < 2; ++n) *(f32x4*)(o + bj * 128 + 4 * n) = h[ai][bj][m][n] * r * gv[bj][n];
        }
    }
};

template <class F> __device__ __forceinline__ void gemm_naive(const bf16* __restrict__ A, const bf16* __restrict__ Bt, int M, int N, int K, const F& f, int gw, int NGW, int lane) {
    const int ntn = N / 64, ntiles = (M / 64) * ntn;
    const int r = lane & 31, h = lane >> 5;
    const int pi = 16 * (r >> 4) + 8 * ((r >> 2) & 1) + (r & 3) + 4 * ((r >> 3) & 1);
    for (int t = gw; t < ntiles; t += NGW) {
        const int row0 = (t / ntn) * 64, col0 = (t % ntn) * 64;
        f32x16 acc[2][2];
#pragma unroll
        for (int i = 0; i < 2; ++i)
#pragma unroll
            for (int j = 0; j < 2; ++j)
#pragma unroll
                for (int e = 0; e < 16; ++e) acc[i][j][e] = 0.f;
        const bf16* pa0 = Bt + (size_t)(col0 + pi) * K + 8 * h; const bf16* pa1 = pa0 + (size_t)32 * K;
        const bf16* pb0 = A + (size_t)(row0 + r) * K + 8 * h;   const bf16* pb1 = pb0 + (size_t)32 * K;
        for (int k0 = 0; k0 < K; k0 += 16) {
            const bf16x8 a0 = *(const bf16x8*)(pa0 + k0), a1 = *(const bf16x8*)(pa1 + k0), b0 = *(const bf16x8*)(pb0 + k0), b1 = *(const bf16x8*)(pb1 + k0);
            acc[0][0] = __builtin_amdgcn_mfma_f32_32x32x16_bf16(a0, b0, acc[0][0], 0, 0, 0);
            acc[0][1] = __builtin_amdgcn_mfma_f32_32x32x16_bf16(a0, b1, acc[0][1], 0, 0, 0);
            acc[1][0] = __builtin_amdgcn_mfma_f32_32x32x16_bf16(a1, b0, acc[1][0], 0, 0, 0);
            acc[1][1] = __builtin_amdgcn_mfma_f32_32x32x16_bf16(a1, b1, acc[1][1], 0, 0, 0);
        }
#pragma unroll
        for (int ni = 0; ni < 2; ++ni)
#pragma unroll
            for (int mi = 0; mi < 2; ++mi) {
                const int row = row0 + 32 * mi + r;
#pragma unroll
                for (int hf = 0; hf < 2; ++hf) {
                    const int col = col0 + 32 * ni + 16 * hf + 8 * h;
                    float v[8];
#pragma unroll
                    for (int i = 0; i < 8; ++i) v[i] = acc[ni][mi][8 * hf + i];
                    typename F::Pre pre; f.load(row, col, pre);
                    const float ss = f.apply(row, col, v, pre);
                    if (F::HAS_SS) atomicAdd(f.ss + row, ss);
                }
            }
    }
}

template <class F> __device__ __forceinline__ void gemm_run(LAS unsigned char* lds, const bf16* A, const bf16* Bt, int M, int N, int K, const F& f, int gw, int NGW, int lane) {
#if USE_PG8
    pg8::Gemm g{A, Bt, M, N, K}; pg8::StaticOrder So; So.init(M, N, (int)gridDim.x, (int)blockIdx.x);
    EpiChunk<F> E{f};
    pg8::gemm_phase<EpiChunk<F>, pg8::StaticOrder, true, true>(lds, g, So, E);
#else
    gemm_naive<F>(A, Bt, M, N, K, f, gw, NGW, lane);
#endif
}

__device__ __forceinline__ void attn_naive(LAS unsigned char* lds, const bf16* __restrict__ Q, const bf16* __restrict__ Kb, const bf16* __restrict__ Vb, bf16* CAT, int gw, int NGW, int wave, int lane) {
    LAS float* qs = (LAS float*)(lds + wave * 2304);
    LAS float* sc = qs + 128;
    for (int it = gw; it < S * NH; it += NGW) {
        const int t = it >> 3, hh = it & 7;
        { const unsigned w = *(const unsigned*)(Q + (size_t)t * 1024 + hh * 128 + 2 * lane); qs[2 * lane] = bflo(w); qs[2 * lane + 1] = bfhi(w); }
        WSYNC();
        float mx = -INFINITY;
        for (int e = lane; e < 387; e += 64) {
            const int p = e / 129, j = e - p * 129; const int d = (p == 0) ? 1 : (p == 1 ? 4 : 16);
            const int pos = t - j * d;
            float s = -INFINITY;
            if (pos >= 0) {
                const bf16* kr = Kb + (size_t)pos * 1024 + hh * 128;
                s = 0.f;
#pragma unroll 4
                for (int c = 0; c < 16; ++c) {
                    const u32x4 kw = *(const u32x4*)(kr + 8 * c);
                    const f32x4 q0 = *(const LAS f32x4*)(qs + 8 * c), q1 = *(const LAS f32x4*)(qs + 8 * c + 4);
                    s += q0[0] * bflo(kw.x) + q0[1] * bfhi(kw.x) + q0[2] * bflo(kw.y) + q0[3] * bfhi(kw.y) + q1[0] * bflo(kw.z) + q1[1] * bfhi(kw.z) + q1[2] * bflo(kw.w) + q1[3] * bfhi(kw.w);
                }
            }
            sc[e] = s; mx = fmaxf(mx, s);
        }
        mx = wave_max(mx);
        float ls = 0.f;
        for (int e = lane; e < 387; e += 64) { const float pe = exp2f(sc[e] - mx); sc[e] = pe; ls += pe; }
        ls = wave_sum(ls);
        WSYNC();
        float o0 = 0.f, o1 = 0.f;
        for (int e = 0; e < 387; ++e) {
            const float pe = sc[e];
            if (pe == 0.f) continue;
            const int p = e / 129, j = e - p * 129; const int d = (p == 0) ? 1 : (p == 1 ? 4 : 16);
            const int pos = t - j * d;
            const unsigned w = *(const unsigned*)(Vb + (size_t)pos * 1024 + hh * 128 + 2 * lane);
            o0 += pe * bflo(w); o1 += pe * bfhi(w);
        }
        const float inv = 1.f / ls;
        *(unsigned*)(CAT + (size_t)t * 2048 + hh * 128 + 2 * lane) = pk2(o0 * inv, o1 * inv);
        WSYNC();
    }
}

__device__ __forceinline__ void s5_naive(LAS unsigned char* lds, const Args& a, const bf16* __restrict__ U, bf16* Y, int g, int wave, int lane) {
    const float* a_re = a.in[3]; const float* a_im = a.in[4]; const float* log_dt = a.in[5]; const float* b_re = a.in[6]; const float* b_im = a.in[7];
    const float* c_re = a.in[8]; const float* c_im = a.in[9]; const float* d_skip = a.in[10];
    LAS float* tmp = (LAS float*)(lds + wave * 4096);
    const int n = lane;
    const float are = a_re[g * 64 + n], aim = a_im[g * 64 + n], dt = expf(log_dt[g]);
    const float er = expf(are * dt), abr = er * cosf(aim * dt), abi = er * sinf(aim * dt);
    const float nr = abr - 1.f, ni = abi, den = are * are + aim * aim;
    const float cr = (nr * are + ni * aim) / den, ci = (ni * are - nr * aim) / den;
    float bbr[16], bbi[16], ccr[16], cci[16];
#pragma unroll
    for (int p = 0; p < 16; ++p) {
        const float br = b_re[(size_t)(g * 64 + n) * 16 + p], bi = b_im[(size_t)(g * 64 + n) * 16 + p];
        bbr[p] = cr * br - ci * bi; bbi[p] = cr * bi + ci * br;
        ccr[p] = c_re[(size_t)(g * 16 + p) * 64 + n]; cci[p] = c_im[(size_t)(g * 16 + p) * 64 + n];
    }
    const int pp = lane >> 2, part = lane & 3;
    const float dsk = d_skip[g * 16 + pp];
    float hr = 0.f, hi = 0.f;
    const bf16* ug = U + (size_t)g * S * 16;
    for (int tb = 0; tb < S; tb += 8) {
        u32x4 ub[8][2];
#pragma unroll
        for (int i = 0; i < 8; ++i) { ub[i][0] = *(const u32x4*)(ug + (size_t)(tb + i) * 16); ub[i][1] = *(const u32x4*)(ug + (size_t)(tb + i) * 16 + 8); }
#pragma unroll
        for (int i = 0; i < 8; ++i) {
            float u[16];
#pragma unroll
            for (int w = 0; w < 4; ++w) { u[2 * w] = bflo(ub[i][0][w]); u[2 * w + 1] = bfhi(ub[i][0][w]); u[8 + 2 * w] = bflo(ub[i][1][w]); u[8 + 2 * w + 1] = bfhi(ub[i][1][w]); }
            float bur = 0.f, bui = 0.f;
#pragma unroll
            for (int p = 0; p < 16; ++p) { bur += bbr[p] * u[p]; bui += bbi[p] * u[p]; }
            const float nhr = abr * hr - abi * hi + bur, nhi = abr * hi + abi * hr + bui; hr = nhr; hi = nhi;
#pragma unroll
            for (int p = 0; p < 16; ++p) tmp[p * 64 + n] = ccr[p] * hr - cci[p] * hi;
            WSYNC();
            float s = 0.f;
#pragma unroll
            for (int k = 0; k < 4; ++k) { const f32x4 v = *(const LAS f32x4*)(tmp + pp * 64 + part * 16 + 4 * k); s += (v[0] + v[1]) + (v[2] + v[3]); }
            s += __shfl_xor(s, 1); s += __shfl_xor(s, 2);
            float uv = 0.f;
#pragma unroll
            for (int q = 0; q < 16; ++q) uv = (pp == q) ? u[q] : uv;
            const float y = gelu_tanh(s + dsk * uv);
            if (part == 0) Y[(size_t)(tb + i) * 1024 + g * 16 + pp] = (bf16)f2bf(y);
            WSYNC();
        }
    }
}
#define XB_TMO      128
#define XB_XCNT(j)  (256  + 64 * (j))
#define XB_XSUB(j)  (1280 + 64 * (j))
#define XB_XGEN(j)  (2304 + 64 * (j))
#define XB_TOP      3328
#define XB_TOPGEN   3392
#define XCD_BAR_WORDS 3456
#define XB_SPIN_CAP (1u << 18)

__device__ __forceinline__ unsigned xb_ld(unsigned* p)              { return __hip_atomic_load(p, __ATOMIC_RELAXED, __HIP_MEMORY_SCOPE_AGENT); }
__device__ __forceinline__ unsigned xb_add(unsigned* p, unsigned v) { return __hip_atomic_fetch_add(p, v, __ATOMIC_RELAXED, __HIP_MEMORY_SCOPE_AGENT); }
__device__ __forceinline__ unsigned xb_xcc_id() { return (unsigned)__builtin_amdgcn_s_getreg((3 << 11) | 20) & 0xFu; }
#define XB_SPIN(cond, bar) do { unsigned _sp = 0; while (cond) { __builtin_amdgcn_s_sleep(1); \
    if ((++_sp & 255u) == 0u) { if (xb_ld(&(bar)[XB_TMO])) break; if (_sp > XB_SPIN_CAP) { atomicAdd(&(bar)[XB_TMO], 1u); break; } } } } while (0)

struct XcdBarrier {
    unsigned* bar; unsigned x;
    volatile LAS unsigned* st;
};

__device__ __forceinline__ XcdBarrier xcd_barrier_post(unsigned* bar, volatile LAS unsigned* st) {
    XcdBarrier b; b.bar = bar; b.x = xb_xcc_id(); b.st = st;
    if (threadIdx.x == 0) (void)xb_add(&bar[XB_XCNT(b.x)], 1u);
    return b;
}
__device__ __forceinline__ void xcd_barrier_complete(unsigned* bar, unsigned x, unsigned& nloc, unsigned& nx) {
    const unsigned G = gridDim.x * gridDim.y * gridDim.z;
    unsigned sum, cnt, mine, sp = 0u;
    for (;;) {
        sum = 0u; cnt = 0u; mine = 0u;
#pragma unroll
        for (unsigned j = 0; j < 16; ++j) { const unsigned c = xb_ld(&bar[XB_XCNT(j)]); sum += c; cnt += (c > 0u) ? 1u : 0u; mine = (j == x) ? c : mine; }
        if (sum == G) break;
        __builtin_amdgcn_s_sleep(1);
        if ((++sp & 255u) == 0u) { if (xb_ld(&bar[XB_TMO])) break; if (sp > XB_SPIN_CAP) { atomicAdd(&bar[XB_TMO], 1u); break; } }
    }
    nloc = mine > 0u ? mine : 1u; nx = cnt > 0u ? cnt : 1u;
}

__device__ __forceinline__ void xcd_barrier(const XcdBarrier& b) {
    asm volatile("s_waitcnt vmcnt(0)" ::: "memory");
    __syncthreads();
    if (threadIdx.x == 0) {
        unsigned* bar = b.bar;
        __builtin_amdgcn_s_waitcnt(0);
        unsigned nloc = b.st[0], nx = b.st[1];
        if (nloc == 0u) { xcd_barrier_complete(bar, b.x, nloc, nx); b.st[0] = nloc; b.st[1] = nx; }
        const unsigned old = xb_add(&bar[XB_XSUB(b.x)], 1u);
        const unsigned gen = old / nloc;
        if (old + 1u == (gen + 1u) * nloc) {
            __builtin_amdgcn_fence(__ATOMIC_RELEASE, "agent");
            asm volatile("s_waitcnt vmcnt(0)" ::: "memory");
            const unsigned og = xb_add(&bar[XB_TOP], 1u);
            const unsigned tg = og / nx;
            if (og + 1u == (tg + 1u) * nx) xb_add(&bar[XB_TOPGEN], 1u);
            else XB_SPIN(xb_ld(&bar[XB_TOPGEN]) == tg, bar);
            __builtin_amdgcn_fence(__ATOMIC_ACQUIRE, "agent");
            xb_add(&bar[XB_XGEN(b.x)], 1u);
            asm volatile("s_waitcnt vmcnt(0)" ::: "memory");
        } else {
            XB_SPIN(xb_ld(&bar[XB_XGEN(b.x)]) == gen, bar);
            __builtin_amdgcn_fence(__ATOMIC_ACQUIRE, "agent");
            asm volatile("s_waitcnt vmcnt(0)" ::: "memory");
        }
    }
    __syncthreads();
}

constexpr int ST = 32, SNC = S / ST;
constexpr size_t WS_MLAG = 4 * MiB;
constexpr size_t WS_SC = 396 * MiB, WS_HP = 412 * MiB, WS_WST = 420 * MiB, WS_WC = 428 * MiB, WS_END2 = 436 * MiB;

__device__ __forceinline__ void s5_table_item(LAS unsigned char* lds, const Args& a, bf16* MLAG, bf16* WST, bf16* WC, int item, int wave, int lane) {
    const float* a_re = a.in[3]; const float* a_im = a.in[4]; const float* log_dt = a.in[5]; const float* b_re = a.in[6]; const float* b_im = a.in[7];
    const float* c_re = a.in[8]; const float* c_im = a.in[9];
    const int g = item >> 5, tau = item & 31, n = lane;
    LAS float* zs = (LAS float*)(lds + wave * 18432);
    const float are = a_re[g * 64 + n], aim = a_im[g * 64 + n], dt = expf(log_dt[g]);
    const float er = expf(are * dt), abr = er * cosf(aim * dt), abi = er * sinf(aim * dt);
    const float e0 = expf(are * dt * (float)tau), w0r = e0 * cosf(aim * dt * (float)tau), w0i = e0 * sinf(aim * dt * (float)tau);
    const float e1 = expf(are * dt * (float)(tau + 1)), w1r = e1 * cosf(aim * dt * (float)(tau + 1)), w1i = e1 * sinf(aim * dt * (float)(tau + 1));
    const float nr = abr - 1.f, ni = abi, den = are * are + aim * aim;
    const float cr = (nr * are + ni * aim) / den, ci = (ni * are - nr * aim) / den;
    float zr[16], zi[16];
#pragma unroll
    for (int q = 0; q < 16; ++q) {
        const float br = b_re[(size_t)(g * 64 + n) * 16 + q], bi = b_im[(size_t)(g * 64 + n) * 16 + q];
        const float bbr = cr * br - ci * bi, bbi = cr * bi + ci * br;
        zr[q] = w0r * bbr - w0i * bbi; zi[q] = w0r * bbi + w0i * bbr;
        zs[n * 16 + q] = zr[q]; zs[1024 + n * 16 + q] = zi[q];
    }
    {
        const int i = 31 - tau;
        bf16* d0 = WST + ((size_t)g * 128 + n) * 512 + i * 16; bf16* d1 = d0 + (size_t)64 * 512;
        u32x4 o;
        o.x = pk2(zr[0], zr[1]); o.y = pk2(zr[2], zr[3]); o.z = pk2(zr[4], zr[5]); o.w = pk2(zr[6], zr[7]); *(u32x4*)d0 = o;
        o.x = pk2(zr[8], zr[9]); o.y = pk2(zr[10], zr[11]); o.z = pk2(zr[12], zr[13]); o.w = pk2(zr[14], zr[15]); *(u32x4*)(d0 + 8) = o;
        o.x = pk2(zi[0], zi[1]); o.y = pk2(zi[2], zi[3]); o.z = pk2(zi[4], zi[5]); o.w = pk2(zi[6], zi[7]); *(u32x4*)d1 = o;
        o.x = pk2(zi[8], zi[9]); o.y = pk2(zi[10], zi[11]); o.z = pk2(zi[12], zi[13]); o.w = pk2(zi[14], zi[15]); *(u32x4*)(d1 + 8) = o;
    }
#pragma unroll
    for (int p = 0; p < 16; ++p) {
        const float cre = c_re[(size_t)(g * 16 + p) * 64 + n], cim = c_im[(size_t)(g * 16 + p) * 64 + n];
        bf16* d = WC + ((size_t)g * 512 + tau * 16 + p) * 128;
        d[n] = (bf16)f2bf(cre * w1r - cim * w1i); d[64 + n] = (bf16)f2bf(-(cre * w1i + cim * w1r));
        zs[2048 + p * 64 + n] = cre; zs[3072 + p * 64 + n] = cim;
    }
    WSYNC();
    {
        const int p = lane >> 2, q0 = 4 * (lane & 3);
        const LAS float* crp = zs + 2048 + p * 64; const LAS float* cip = zs + 3072 + p * 64;
        float acc[4] = {0.f, 0.f, 0.f, 0.f};
#pragma unroll 8
        for (int m = 0; m < 64; ++m) {
            const float cre = crp[m], cim = cip[m];
            const f32x4 vr = *(const LAS f32x4*)(zs + m * 16 + q0), vi = *(const LAS f32x4*)(zs + 1024 + m * 16 + q0);
#pragma unroll
            for (int i = 0; i < 4; ++i) acc[i] += cre * vr[i] - cim * vi[i];
        }
        u32x2 o; o.x = pk2(acc[0], acc[1]); o.y = pk2(acc[2], acc[3]);
        *(u32x2*)(MLAG + ((size_t)g * 32 + tau) * 256 + p * 16 + q0) = o;
    }
    WSYNC();
}

__device__ __forceinline__ void s5_state_item(const bf16* __restrict__ WST, const bf16* __restrict__ U, float* SC, int item, int lane) {
    const int half = item & 1, g = item >> 5, ct = (item >> 1) & 15, r = lane & 31, h = lane >> 5, c = ct * 32 + r;
    f32x16 acc[2];
#pragma unroll
    for (int i = 0; i < 2; ++i)
#pragma unroll
        for (int e = 0; e < 16; ++e) acc[i][e] = 0.f;
    const bf16* ub = U + ((size_t)g * S + (size_t)c * 32) * 16 + 8 * h;
    const bf16* wb = WST + ((size_t)g * 128 + 64 * half + r) * 512 + 8 * h;
#pragma unroll 8
    for (int ks = 0; ks < 32; ++ks) {
        const bf16x8 b = *(const bf16x8*)(ub + ks * 16);
#pragma unroll
        for (int rt = 0; rt < 2; ++rt) { const bf16x8 av = *(const bf16x8*)(wb + (size_t)rt * 32 * 512 + ks * 16); acc[rt] = __builtin_amdgcn_mfma_f32_32x32x16_bf16(av, b, acc[rt], 0, 0, 0); }
    }
    float* o = SC + ((size_t)g * SNC + c) * 128 + 64 * half;
#pragma unroll
    for (int rt = 0; rt < 2; ++rt)
#pragma unroll
        for (int eg = 0; eg < 4; ++eg) { f32x4 v = {acc[rt][4 * eg], acc[rt][4 * eg + 1], acc[rt][4 * eg + 2], acc[rt][4 * eg + 3]}; *(f32x4*)(o + 32 * rt + 8 * eg + 4 * h) = v; }
}

__device__ __forceinline__ void s5_state_block(LAS unsigned char* lds, const bf16* __restrict__ WST, const bf16* __restrict__ U, float* SC, int vb, int tid, int wave, int lane) {
    constexpr int WROW = 1040;
    const int g = vb >> 2;
    LBAR();
    { const u32x4* src = (const u32x4*)(WST + (size_t)g * 128 * 512);
      u32x4 tmp[16];
#pragma unroll
      for (int i = 0; i < 16; ++i) tmp[i] = src[tid + 512 * i];
#pragma unroll
      for (int i = 0; i < 16; ++i) { const int chunk = tid + 512 * i, row = chunk >> 6, ch = chunk & 63; *(LAS u32x4*)(lds + row * WROW + ch * 16) = tmp[i]; } }
    LBAR();
    const int half = wave & 1, ct = 4 * (vb & 3) + (wave >> 1), r = lane & 31, h = lane >> 5, c = ct * 32 + r;
    f32x16 acc[2];
#pragma unroll
    for (int i = 0; i < 2; ++i)
#pragma unroll
        for (int e = 0; e < 16; ++e) acc[i][e] = 0.f;
    const bf16* ub = U + ((size_t)g * S + (size_t)c * 32) * 16 + 8 * h;
    const LAS unsigned char* wl = lds + (64 * half + r) * WROW + h * 16;
    bf16x8 bfr[32];
#pragma unroll
    for (int ks = 0; ks < 32; ++ks) bfr[ks] = *(const bf16x8*)(ub + ks * 16);
#pragma unroll
    for (int ks = 0; ks < 32; ++ks) {
#pragma unroll
        for (int rt = 0; rt < 2; ++rt) { const bf16x8 av = *(const LAS bf16x8*)(wl + rt * 32 * WROW + ks * 32); acc[rt] = __builtin_amdgcn_mfma_f32_32x32x16_bf16(av, bfr[ks], acc[rt], 0, 0, 0); }
    }
    float* o = SC + ((size_t)g * SNC + c) * 128 + 64 * half;
#pragma unroll
    for (int rt = 0; rt < 2; ++rt)
#pragma unroll
        for (int eg = 0; eg < 4; ++eg) { f32x4 v = {acc[rt][4 * eg], acc[rt][4 * eg + 1], acc[rt][4 * eg + 2], acc[rt][4 * eg + 3]}; *(f32x4*)(o + 32 * rt + 8 * eg + 4 * h) = v; }
}

__device__ __forceinline__ void s5_state_block2(LAS unsigned char* lds, const bf16* __restrict__ WST, const bf16* __restrict__ U, float* SC, int vb, int tid, int wave, int lane) {
    constexpr int PR = 528, UOFF2 = 128 * PR;
    const int g = vb >> 2, ct0 = 4 * (vb & 3);
    const int half = wave & 1, ctl = wave >> 1, r = lane & 31, h = lane >> 5;
    f32x16 acc[2];
#pragma unroll
    for (int i = 0; i < 2; ++i)
#pragma unroll
        for (int e = 0; e < 16; ++e) acc[i][e] = 0.f;
    const LAS unsigned char* wl = lds + (64 * half + r) * PR + h * 16;
    const LAS unsigned char* ul = lds + UOFF2 + (ctl * 32 + r) * PR + h * 16;
#pragma unroll 1
    for (int kh = 0; kh < 2; ++kh) {
        u32x4 tw[8], tu[8];
#pragma unroll
        for (int i = 0; i < 8; ++i) { const int idx = tid + 512 * i, row = idx >> 5, pc = idx & 31;
            tw[i] = *(const u32x4*)(WST + ((size_t)g * 128 + row) * 512 + kh * 256 + pc * 8);
            tu[i] = *(const u32x4*)(U + ((size_t)g * S + (size_t)(ct0 * 32 + row) * 32 + kh * 16) * 16 + pc * 8); }
        __syncthreads();
#pragma unroll
        for (int i = 0; i < 8; ++i) { const int idx = tid + 512 * i, row = idx >> 5, pc = idx & 31;
            *(LAS u32x4*)(lds + row * PR + pc * 16) = tw[i]; *(LAS u32x4*)(lds + UOFF2 + row * PR + pc * 16) = tu[i]; }
        __syncthreads();
#pragma unroll
        for (int ksl = 0; ksl < 16; ++ksl) {
            const bf16x8 bv = *(const LAS bf16x8*)(ul + 32 * ksl);
#pragma unroll
            for (int rt = 0; rt < 2; ++rt) { const bf16x8 av = *(const LAS bf16x8*)(wl + rt * 32 * PR + 32 * ksl); acc[rt] = __builtin_amdgcn_mfma_f32_32x32x16_bf16(av, bv, acc[rt], 0, 0, 0); }
        }
    }
    const int c = (ct0 + ctl) * 32 + r;
    float* o = SC + ((size_t)g * SNC + c) * 128 + 64 * half;
#pragma unroll
    for (int rt = 0; rt < 2; ++rt)
#pragma unroll
        for (int eg = 0; eg < 4; ++eg) { f32x4 v = {acc[rt][4 * eg], acc[rt][4 * eg + 1], acc[rt][4 * eg + 2], acc[rt][4 * eg + 3]}; *(f32x4*)(o + 32 * rt + 8 * eg + 4 * h) = v; }
}

__device__ __forceinline__ void s5_scan_block(LAS unsigned char* lds, const Args& a, const float* __restrict__ SC, bf16* HP, int g, int wave, int lane) {
    const int n = lane;
    const float are = a.in[3][g * 64 + n], aim = a.in[4][g * 64 + n], dt = expf(a.in[5][g]);
    const float eT = expf(are * dt * (float)ST), atr = eT * cosf(aim * dt * (float)ST), ati = eT * sinf(aim * dt * (float)ST);
    const float eS = expf(are * dt * (float)(ST * 64)), asr = eS * cosf(aim * dt * (float)(ST * 64)), asi = eS * sinf(aim * dt * (float)(ST * 64));
    const int c0 = wave * 64;
    const float* sc = SC + ((size_t)g * SNC + c0) * 128; bf16* hp = HP + ((size_t)g * SNC + c0) * 128;
    LAS float* ex = (LAS float*)lds;
    float sr0[16], si0[16];
#define S5_LOAD(SR, SI, cb) do { _Pragma("unroll") for (int i = 0; i < 16; ++i) { SR[i] = sc[(size_t)((cb) + i) * 128 + n]; SI[i] = sc[(size_t)((cb) + i) * 128 + 64 + n]; } } while (0)
#define S5_ACC(SR, SI) do { _Pragma("unroll") for (int i = 0; i < 16; ++i) { const float nhr = atr * hr - ati * hi + SR[i], nhi = atr * hi + ati * hr + SI[i]; hr = nhr; hi = nhi; } } while (0)
#define S5_STEP(SR, SI, cb) do { _Pragma("unroll") for (int i = 0; i < 16; ++i) { \
        hp[(size_t)((cb) + i) * 128 + n] = (bf16)f2bf(hr); hp[(size_t)((cb) + i) * 128 + 64 + n] = (bf16)f2bf(hi); \
        const float nhr = atr * hr - ati * hi + SR[i], nhi = atr * hi + ati * hr + SI[i]; hr = nhr; hi = nhi; } } while (0)
    float hr = 0.f, hi = 0.f;
    for (int cb = 0; cb < 64; cb += 16) { S5_LOAD(sr0, si0, cb); S5_ACC(sr0, si0); }
    LBAR();
    ex[wave * 128 + n] = hr; ex[wave * 128 + 64 + n] = hi;
    LBAR();
    hr = 0.f; hi = 0.f;
    for (int w = 0; w < wave; ++w) { const float er = ex[w * 128 + n], ei = ex[w * 128 + 64 + n]; const float nhr = asr * hr - asi * hi + er, nhi = asr * hi + asi * hr + ei; hr = nhr; hi = nhi; }
    for (int cb = 0; cb < 64; cb += 16) { S5_LOAD(sr0, si0, cb); S5_STEP(sr0, si0, cb); }
#undef S5_LOAD
#undef S5_ACC
#undef S5_STEP
}

__device__ __forceinline__ void s5_out_block(LAS unsigned char* lds, const bf16* __restrict__ MLAG, const bf16* __restrict__ WC, const bf16* __restrict__ HP, const bf16* __restrict__ U,
                                             const float* __restrict__ d_skip, bf16* Y, int vb, int tid, int wave, int lane) {
    const int g = vb >> 2, ct = 4 * (vb & 3) + (wave >> 1), half = wave & 1;
    __syncthreads();
    { const u32x4* src = (const u32x4*)(MLAG + (size_t)g * 8192); LAS u32x4* dst = (LAS u32x4*)lds; dst[tid] = src[tid]; dst[tid + 512] = src[tid + 512]; }
    __syncthreads();
    const int r = lane & 31, h = lane >> 5, c = ct * 32 + r, rj = r >> 4, rp = r & 15;
    const bf16* ub = U + ((size_t)g * S + (size_t)c * 32) * 16 + 8 * h;
    const bf16* hpb = HP + ((size_t)g * SNC + c) * 128 + 8 * h;
    bf16x8 hp[8];
#pragma unroll
    for (int ks = 0; ks < 8; ++ks) hp[ks] = *(const bf16x8*)(hpb + 16 * ks);
    const LAS unsigned char* ml = lds + rp * 32 + h * 16;
    for (int pass = 0; pass < 2; ++pass) {
        const int jg = half ? (1 + pass) : (3 * pass);
        f32x16 acc[4];
#pragma unroll
        for (int i = 0; i < 4; ++i)
#pragma unroll
            for (int e = 0; e < 16; ++e) acc[i][e] = 0.f;
#pragma unroll
        for (int jl = 0; jl < 4; ++jl) {
            const bf16* wcb = WC + ((size_t)g * 512 + (4 * jg + jl) * 32 + r) * 128 + 8 * h;
#pragma unroll
            for (int ks = 0; ks < 8; ++ks) { const bf16x8 av = *(const bf16x8*)(wcb + 16 * ks); acc[jl] = __builtin_amdgcn_mfma_f32_32x32x16_bf16(av, hp[ks], acc[jl], 0, 0, 0); }
        }
        const int nkb = jg + 1;
        bf16x8 bA[8], bB[8];
#define S5_BLOAD(BF, kb) do { _Pragma("unroll") for (int q_ = 0; q_ < 8; ++q_) BF[q_] = *(const bf16x8*)(ub + ((kb) * 8 + q_) * 16); } while (0)
#define S5_BMMA(BF, kb) do { _Pragma("unroll") for (int q_ = 0; q_ < 8; ++q_) { const int ks = (kb) * 8 + q_; \
            _Pragma("unroll") for (int jl = 0; jl < 4; ++jl) { const int jj = 4 * jg + jl; \
                if (2 * jj + 1 - ks >= 0) { const int tau = 2 * jj + rj - ks; const int tc = tau < 0 ? 0 : tau; \
                    bf16x8 av = *(const LAS bf16x8*)(ml + tc * 512); if (tau < 0) av = (bf16x8){0, 0, 0, 0, 0, 0, 0, 0}; \
                    acc[jl] = __builtin_amdgcn_mfma_f32_32x32x16_bf16(av, BF[q_], acc[jl], 0, 0, 0); } } } } while (0)
        S5_BLOAD(bA, 0);
        for (int kb = 0; kb < nkb; kb += 2) {
            if (kb + 1 < nkb) S5_BLOAD(bB, kb + 1);
            S5_BMMA(bA, kb);
            if (kb + 1 < nkb) {
                if (kb + 2 < nkb) S5_BLOAD(bA, kb + 2);
                S5_BMMA(bB, kb + 1);
            }
        }
#undef S5_BLOAD
#undef S5_BMMA
#pragma unroll
        for (int jl = 0; jl < 4; ++jl)
#pragma unroll
            for (int eg = 0; eg < 4; ++eg) {
                const int j = 2 * (4 * jg + jl) + (eg >> 1), p0 = 8 * (eg & 1) + 4 * h, t = c * 32 + j;
                const u32x2 uw = *(const u32x2*)(U + ((size_t)g * S + t) * 16 + p0);
                const f32x4 d = *(const f32x4*)(d_skip + g * 16 + p0);
                const float y0 = gelu_tanh(acc[jl][4 * eg + 0] + d[0] * bflo(uw.x)), y1 = gelu_tanh(acc[jl][4 * eg + 1] + d[1] * bfhi(uw.x));
                const float y2 = gelu_tanh(acc[jl][4 * eg + 2] + d[2] * bflo(uw.y)), y3 = gelu_tanh(acc[jl][4 * eg + 3] + d[3] * bfhi(uw.y));
                u32x2 o; o.x = pk2(y0, y1); o.y = pk2(y2, y3);
                *(u32x2*)(Y + (size_t)t * 1024 + g * 16 + p0) = o;
            }
    }
}

__device__ __forceinline__ void s5_out_block2(LAS unsigned char* lds, const bf16* __restrict__ MLAG, const bf16* __restrict__ WC, const bf16* __restrict__ HP, const bf16* __restrict__ U,
                                              const float* __restrict__ d_skip, bf16* Y, int vb, int tid, int wave, int lane) {
    constexpr int UOFF = 16384, UROW = 1040, HOFF = UOFF + 32 * UROW, HROW = 272;
    const int g = vb >> 2;
    const int r = lane & 31, h = lane >> 5, rj = r >> 4, rp = r & 15;
    LBAR();
    { const u32x4* src = (const u32x4*)(MLAG + (size_t)g * 8192); LAS u32x4* dst = (LAS u32x4*)lds; dst[tid] = src[tid]; dst[tid + 512] = src[tid + 512]; }
    const LAS unsigned char* ml = lds + rp * 32 + h * 16;
    const LAS unsigned char* ul = lds + UOFF + r * UROW + h * 16;
    const LAS unsigned char* hl = lds + HOFF + r * HROW + h * 16;
    const f32x4 dA = *(const f32x4*)(d_skip + g * 16 + 4 * h), dB = *(const f32x4*)(d_skip + g * 16 + 8 + 4 * h);
    bf16x8 wc[2][8];
#pragma unroll
    for (int q = 0; q < 2; ++q) { const int jj = q ? 15 - wave : wave; const bf16* wcb = WC + ((size_t)g * 512 + jj * 32 + r) * 128 + 8 * h;
#pragma unroll
        for (int ks = 0; ks < 8; ++ks) wc[q][ks] = *(const bf16x8*)(wcb + 16 * ks); }
    for (int it = 0; it < 4; ++it) {
        const int ct = 4 * (vb & 3) + it;
        LBAR();
        { const u32x4* us = (const u32x4*)(U + ((size_t)g * S + (size_t)ct * 1024) * 16);
#pragma unroll
          for (int i = 0; i < 4; ++i) { const int idx = tid + 512 * i; *(LAS u32x4*)(lds + UOFF + (idx >> 6) * UROW + (idx & 63) * 16) = us[idx]; }
          const u32x4* hs = (const u32x4*)(HP + ((size_t)g * SNC + ct * 32) * 128);
          *(LAS u32x4*)(lds + HOFF + (tid >> 4) * HROW + (tid & 15) * 16) = hs[tid]; }
        LBAR();
#pragma unroll
        for (int q = 0; q < 2; ++q) {
            const int jj = q ? 15 - wave : wave;
            f32x16 acc;
#pragma unroll
            for (int e = 0; e < 16; ++e) acc[e] = 0.f;
#pragma unroll
            for (int ks = 0; ks < 8; ++ks) { const bf16x8 bv = *(const LAS bf16x8*)(hl + 32 * ks); acc = __builtin_amdgcn_mfma_f32_32x32x16_bf16(wc[q][ks], bv, acc, 0, 0, 0); }
            const int kend = 2 * jj + 2;
#pragma unroll 2
            for (int ks = 0; ks < kend; ++ks) {
                const bf16x8 bv = *(const LAS bf16x8*)(ul + 32 * ks);
                const int tau = 2 * jj + rj - ks; const int tc = tau < 0 ? 0 : tau;
                bf16x8 av = *(const LAS bf16x8*)(ml + tc * 512); if (tau < 0) av = (bf16x8){0, 0, 0, 0, 0, 0, 0, 0};
                acc = __builtin_amdgcn_mfma_f32_32x32x16_bf16(av, bv, acc, 0, 0, 0);
            }
            const int c = ct * 32 + r;
#pragma unroll
            for (int ep = 0; ep < 2; ++ep) {
                const int j = 2 * jj + ep, t = c * 32 + j;
                unsigned pk[2][2];
#pragma unroll
                for (int q2 = 0; q2 < 2; ++q2) {
                    const int eg = 2 * ep + q2, p0 = 8 * q2 + 4 * h;
                    const u32x2 uw = *(const LAS u32x2*)(lds + UOFF + r * UROW + j * 32 + p0 * 2);
                    const f32x4 d = q2 ? dB : dA;
                    const float y0 = gelu_tanh(acc[4 * eg + 0] + d[0] * bflo(uw.x)), y1 = gelu_tanh(acc[4 * eg + 1] + d[1] * bfhi(uw.x));
                    const float y2 = gelu_tanh(acc[4 * eg + 2] + d[2] * bflo(uw.y)), y3 = gelu_tanh(acc[4 * eg + 3] + d[3] * bfhi(uw.y));
                    pk[q2][0] = pk2(y0, y1); pk[q2][1] = pk2(y2, y3);
                }
                { auto rx = __builtin_amdgcn_permlane32_swap(pk[0][0], pk[1][0], false, false); pk[0][0] = rx[0]; pk[1][0] = rx[1]; }
                { auto ry = __builtin_amdgcn_permlane32_swap(pk[0][1], pk[1][1], false, false); pk[0][1] = ry[0]; pk[1][1] = ry[1]; }
                u32x4 o = {pk[0][0], pk[0][1], pk[1][0], pk[1][1]};
                *(u32x4*)(Y + (size_t)t * 1024 + g * 16 + 8 * h) = o;
            }
        }
    }
}

constexpr size_t WS_PM = 5 * MiB, WS_END3 = 500 * MiB;
__device__ __forceinline__ bf16* po_base(unsigned char* ws, int pat) { return (bf16*)(ws + (pat < 2 ? 436 * MiB + (size_t)pat * 32 * MiB : WS_Y)); }
constexpr int VROW = 320;
typedef short v4i16_t __attribute__((ext_vector_type(4)));
typedef short s16x4 __attribute__((ext_vector_type(4)));
__device__ __forceinline__ unsigned cvtpk_s(float lo, float hi) { return pk2(lo, hi); }
__device__ __forceinline__ s16x4 vtr(const LAS unsigned char* p) { return __builtin_bit_cast(s16x4, __builtin_amdgcn_ds_read_tr16_b64_v4i16((LAS v4i16_t*)p)); }

constexpr int KROW = 272;
struct AttnItem { int pat, hh, d, res, lq0; };
__device__ __forceinline__ AttnItem attn_decode(int item) {
    AttnItem I; I.pat = item >> 9; const int rem = item & 511, x = rem >> 3, shift = 2 * I.pat, nsb = 64 >> shift;
    I.hh = rem & 7; I.d = 1 << shift; I.res = x >> (6 - shift); I.lq0 = (x & (nsb - 1)) * 256; return I;
}
__device__ __forceinline__ void attn_phase(LAS unsigned char* lds, const bf16* __restrict__ Q, const bf16* __restrict__ Kb, const bf16* __restrict__ Vb, unsigned char* ws, float* PM, int tid, int wave, int lane) {
    const int r = lane & 31, h = lane >> 5;
    int it = blockIdx.x;
    if (it >= 1536) return;
    AttnItem I = attn_decode(it);
    u32x4 stg[12]; bf16x8 qf[8];
#define ATT_STAGE_LOAD(SRC, IT) do { _Pragma("unroll") for (int i_ = 0; i_ < 12; ++i_) { const int chunk_ = tid + 512 * i_, rr_ = chunk_ >> 4, ch_ = chunk_ & 15, lv_ = (IT).lq0 - 128 + rr_; \
        u32x4 val_ = {0u, 0u, 0u, 0u}; if (lv_ >= 0) val_ = *(const u32x4*)((SRC) + ((size_t)lv_ * (IT).d + (IT).res) * 1024 + (IT).hh * 128 + ch_ * 8); stg[i_] = val_; } } while (0)
#define ATT_STAGE_WRITE(ROWB) do { _Pragma("unroll") for (int i_ = 0; i_ < 12; ++i_) { const int chunk_ = tid + 512 * i_, rr_ = chunk_ >> 4, ch_ = chunk_ & 15; *(LAS u32x4*)(lds + rr_ * (ROWB) + ch_ * 16) = stg[i_]; } } while (0)
#define ATT_QLOAD(IT) do { const size_t qp_ = (size_t)((IT).lq0 + 32 * wave + r) * (IT).d + (IT).res; const bf16* q_ = Q + qp_ * 1024 + (IT).hh * 128 + 8 * h; \
        _Pragma("unroll") for (int s_ = 0; s_ < 8; ++s_) qf[s_] = *(const bf16x8*)(q_ + 16 * s_); } while (0)
    ATT_STAGE_LOAD(Kb, I); ATT_QLOAD(I);
    for (;;) {
        LBAR();
        ATT_STAGE_WRITE(KROW);
        LBAR();
        ATT_STAGE_LOAD(Vb, I);
        f32x16 sacc[5];
        const LAS unsigned char* kb = lds + (32 * wave + r) * KROW + h * 16;
        const int lkw = I.lq0 - 128 + 32 * wave;
#pragma unroll
        for (int i = 0; i < 5; ++i) {
#pragma unroll
            for (int e = 0; e < 16; ++e) sacc[i][e] = 0.f;
#pragma unroll
            for (int s = 0; s < 8; ++s) { const bf16x8 kf = *(const LAS bf16x8*)(kb + (32 * i) * KROW + 32 * s); sacc[i] = __builtin_amdgcn_mfma_f32_32x32x16_bf16(kf, qf[s], sacc[i], 0, 0, 0); }
        }
#pragma unroll
        for (int e = 0; e < 16; ++e) { const int kv = (e & 3) + 8 * (e >> 2) + 4 * h; if (kv < r) sacc[0][e] = -INFINITY; if (kv > r) sacc[4][e] = -INFINITY; }
#pragma unroll
        for (int i = 0; i < 4; ++i) if (lkw + 32 * i < 0) {
#pragma unroll
            for (int e = 0; e < 16; ++e) sacc[i][e] = -INFINITY;
        }
        float m = sacc[4][0];
#pragma unroll
        for (int i = 0; i < 5; ++i)
#pragma unroll
            for (int e = 0; e < 16; ++e) m = fmaxf(m, sacc[i][e]);
        { auto rr = __builtin_amdgcn_permlane32_swap(__float_as_uint(m), __float_as_uint(m), false, false); m = fmaxf(__uint_as_float(rr[0]), __uint_as_float(rr[1])); }
        float l = 0.f; u32x4 pw[5][2];
#pragma unroll
        for (int i = 0; i < 5; ++i) {
#pragma unroll
            for (int e = 0; e < 16; ++e) { sacc[i][e] = __builtin_amdgcn_exp2f(sacc[i][e] - m); l += sacc[i][e]; }
#pragma unroll
            for (int s2 = 0; s2 < 2; ++s2) { pw[i][s2].x = pk2(sacc[i][8 * s2], sacc[i][8 * s2 + 1]); pw[i][s2].y = pk2(sacc[i][8 * s2 + 2], sacc[i][8 * s2 + 3]); pw[i][s2].z = pk2(sacc[i][8 * s2 + 4], sacc[i][8 * s2 + 5]); pw[i][s2].w = pk2(sacc[i][8 * s2 + 6], sacc[i][8 * s2 + 7]); }
        }
        { auto rr = __builtin_amdgcn_permlane32_swap(__float_as_uint(l), __float_as_uint(l), false, false); l = __uint_as_float(rr[0]) + __uint_as_float(rr[1]); }
        LBAR();
        ATT_STAGE_WRITE(VROW);
        LBAR();
        const AttnItem C = I;
        const int nxt = it + (int)gridDim.x; const bool more = nxt < 1536;
        if (more) { I = attn_decode(nxt); ATT_STAGE_LOAD(Kb, I); ATT_QLOAD(I); }
        f32x16 oacc[4];
#pragma unroll
        for (int i = 0; i < 4; ++i)
#pragma unroll
            for (int e = 0; e < 16; ++e) oacc[i][e] = 0.f;
        const LAS unsigned char* vbase = lds + (32 * wave + 4 * h + ((lane & 15) >> 2)) * VROW + (16 * ((lane >> 4) & 1) + 4 * (lane & 3)) * 2;
#pragma unroll
        for (int i = 0; i < 5; ++i)
#pragma unroll
            for (int s2 = 0; s2 < 2; ++s2)
#pragma unroll
                for (int db = 0; db < 4; ++db) {
                    const s16x4 lo = vtr(vbase + (32 * i + 16 * s2) * VROW + db * 64), hi = vtr(vbase + (32 * i + 16 * s2 + 8) * VROW + db * 64);
                    const bf16x8 av = {lo[0], lo[1], lo[2], lo[3], hi[0], hi[1], hi[2], hi[3]};
                    oacc[db] = __builtin_amdgcn_mfma_f32_32x32x16_bf16(av, __builtin_bit_cast(bf16x8, pw[i][s2]), oacc[db], 0, 0, 0);
                }
        const float inv = 1.f / l;
        const size_t qpos = (size_t)(C.lq0 + 32 * wave + r) * C.d + C.res;
        unsigned char* po = (unsigned char*)(po_base(ws, C.pat) + qpos * 1024 + C.hh * 128) + (h ? 16 : 0);
#pragma unroll
        for (int db = 0; db < 4; ++db)
#pragma unroll
            for (int ep = 0; ep < 2; ++ep) {
                const int e0 = 2 * ep, e1 = 2 * ep + 1;
                unsigned ax = pk2(oacc[db][4 * e0] * inv, oacc[db][4 * e0 + 1] * inv), ay = pk2(oacc[db][4 * e0 + 2] * inv, oacc[db][4 * e0 + 3] * inv);
                unsigned bx = pk2(oacc[db][4 * e1] * inv, oacc[db][4 * e1 + 1] * inv), by = pk2(oacc[db][4 * e1 + 2] * inv, oacc[db][4 * e1 + 3] * inv);
                { auto rx = __builtin_amdgcn_permlane32_swap(ax, bx, false, false); ax = rx[0]; bx = rx[1]; }
                { auto ry = __builtin_amdgcn_permlane32_swap(ay, by, false, false); ay = ry[0]; by = ry[1]; }
                u32x4 o = {ax, ay, bx, by};
                *(u32x4*)(po + 16 * (4 * db + e0)) = o;
            }
        if (h == 0) { f32x2_t ml = {m, l}; *(f32x2_t*)(PM + (((size_t)C.pat * S + qpos) * 8 + C.hh) * 2) = ml; }
        if (!more) break;
        it = nxt;
    }
#undef ATT_STAGE_LOAD
#undef ATT_STAGE_WRITE
#undef ATT_QLOAD
}

__device__ __forceinline__ void attn_combine(unsigned char* ws, const float* __restrict__ PM, bf16* CAT, int gtid, int gthreads, int iend = S * 128) {
    for (int idx = gtid; idx < iend; idx += gthreads) {
        const int t = idx >> 7, c = (idx & 127) * 8, hh = c >> 7;
        float mm[3], ll[3];
#pragma unroll
        for (int p = 0; p < 3; ++p) { const f32x2_t ml = *(const f32x2_t*)(PM + (((size_t)p * S + t) * 8 + hh) * 2); mm[p] = ml[0]; ll[p] = ml[1]; }
        const float ma = fmaxf(mm[0], fmaxf(mm[1], mm[2]));
        float w[3], den = 0.f;
#pragma unroll
        for (int p = 0; p < 3; ++p) { w[p] = exp2f(mm[p] - ma) * ll[p]; den += w[p]; }
        const float inv = 1.f / den;
        float o[8] = {0.f, 0.f, 0.f, 0.f, 0.f, 0.f, 0.f, 0.f};
#pragma unroll
        for (int p = 0; p < 3; ++p) {
            const u32x4 v = *(const u32x4*)(po_base(ws, p) + (size_t)t * 1024 + c); const float wp = w[p] * inv;
            o[0] += wp * bflo(v.x); o[1] += wp * bfhi(v.x); o[2] += wp * bflo(v.y); o[3] += wp * bfhi(v.y); o[4] += wp * bflo(v.z); o[5] += wp * bfhi(v.z); o[6] += wp * bflo(v.w); o[7] += wp * bfhi(v.w);
        }
        u32x4 ov; ov.x = pk2(o[0], o[1]); ov.y = pk2(o[2], o[3]); ov.z = pk2(o[4], o[5]); ov.w = pk2(o[6], o[7]);
        *(u32x4*)(CAT + (size_t)t * 2048 + c) = ov;
    }
}
__global__ void __launch_bounds__(512, 2) mega(Args a) {
    extern __shared__ __attribute__((aligned(16))) unsigned char lds_raw[];
    LAS unsigned char* lds = (LAS unsigned char*)lds_raw;
    const int tid = threadIdx.x, lane = tid & 63, wave = __builtin_amdgcn_readfirstlane(tid >> 6);
    const int gw = blockIdx.x * 8 + wave, NGW = gridDim.x * 8;
    unsigned char* ws = a.ws;
    float* SS2 = (float*)(ws + WS_SS2); float* SS3 = (float*)(ws + WS_SS3); float* R1 = (float*)(ws + WS_R1);
    float* RC = (float*)(ws + WS_ROPEC); float* RS = (float*)(ws + WS_ROPES);
    bf16* WIN = (bf16*)(ws + WS_WIN); bf16* WGLU = (bf16*)(ws + WS_WGLU); bf16* WOUT = (bf16*)(ws + WS_WOUT); bf16* WGU = (bf16*)(ws + WS_WGU); bf16* WDN = (bf16*)(ws + WS_WDN);
    bf16* XB = (bf16*)(ws + WS_XB); bf16* Qb = (bf16*)(ws + WS_Q); bf16* Kb = (bf16*)(ws + WS_K); bf16* Vb = (bf16*)(ws + WS_V); bf16* Ub = (bf16*)(ws + WS_U);
    bf16* Yb = (bf16*)(ws + WS_Y); bf16* CAT = (bf16*)(ws + WS_CAT); bf16* HH = (bf16*)(ws + WS_HH);
    bf16* MLAG = (bf16*)(ws + WS_MLAG); bf16* WST = (bf16*)(ws + WS_WST); bf16* WC = (bf16*)(ws + WS_WC); float* SC = (float*)(ws + WS_SC); bf16* HP = (bf16*)(ws + WS_HP);
    float* PM = (float*)(ws + WS_PM);
    const int lo = a.ph_lo, hi = a.ph_hi;
    cg::grid_group grid = cg::this_grid();
    volatile LAS unsigned* bst = (volatile LAS unsigned*)(lds + LDS_CTL);
    if (tid < 2) bst[tid] = 0u;
    __syncthreads();
    unsigned* barw = (unsigned*)(ws + WS_BAR);
    XcdBarrier xb = xcd_barrier_post(barw, bst);
    if (lo == -2) grid.sync();
#define IN(k) (lo <= (k) && (k) < hi)
#define SEAM(k) do { if (IN(k) && IN((k) + 1)) xcd_barrier(xb); } while (0)

    if (IN(0)) {
#if !NAIVE_S5
        if (gw & 1) for (int it = gw; it < NG * ST; it += NGW) s5_table_item(lds, a, MLAG, WST, WC, it, wave, lane);
#endif
        LAS float* scr = (LAS float*)(lds + wave * 18432);
        constexpr int I_IN = 32 * 64, I_GLU = 16 * 16, I_OUT = 32 * 32, I_G = 32 * 88, I_D = 88 * 32;
        constexpr int NITEMS = I_IN + I_GLU + I_OUT + 2 * I_G + I_D;
        for (int it = gw; it < NITEMS; it += NGW) {
            int r = it;
            if (r < I_IN) { conv_item(a.in[2], 2048, 4096, WIN, a.in[1], 1, scr, r, lane); continue; } r -= I_IN;
            if (r < I_GLU) { conv_item(a.in[11], 1024, 1024, WGLU, nullptr, 0, scr, r, lane); continue; } r -= I_GLU;
            if (r < I_OUT) { conv_item(a.in[13], 2048, 2048, WOUT, nullptr, 0, scr, r, lane); continue; } r -= I_OUT;
            if (r < I_G) { conv_item(a.in[15], 2048, DFF, WGU, a.in[14], 2, scr, r, lane); continue; } r -= I_G;
            if (r < I_G) { conv_item(a.in[16], 2048, DFF, WGU, a.in[14], 3, scr, r, lane); continue; } r -= I_G;
            conv_item(a.in[17], DFF, 2048, WDN, nullptr, 0, scr, r, lane);
        }
#if !NAIVE_S5
        if (!(gw & 1)) for (int it = gw; it < NG * ST; it += NGW) s5_table_item(lds, a, MLAG, WST, WC, it, wave, lane);
#endif
        for (int idx = gw * 64 + lane; idx < S * 16; idx += NGW * 64) {
            const int pos = idx >> 4, i = idx & 15;
            const float invf = powf(500000.f, -(float)i * (1.f / 16.f));
            const float ang = (float)pos * invf;
            RC[idx] = cosf(ang); RS[idx] = sinf(ang);
        }
        const float* x = a.in[0];
        for (int row = gw; row < S; row += 2 * NGW) {
            const int row2 = row + NGW;
            const bool has2 = row2 < S;
            const f32x4* xr = (const f32x4*)(x + (size_t)row * 2048) + lane; const f32x4* xr2 = (const f32x4*)(x + (size_t)(has2 ? row2 : row) * 2048) + lane;
            f32x4 v[8], v2[8]; float s = 0.f, s2 = 0.f;
#pragma unroll
            for (int j = 0; j < 8; ++j) { v[j] = __builtin_nontemporal_load(xr + 64 * j); v2[j] = __builtin_nontemporal_load(xr2 + 64 * j); }
#pragma unroll
            for (int j = 0; j < 8; ++j) { s += (v[j][0] * v[j][0] + v[j][1] * v[j][1]) + (v[j][2] * v[j][2] + v[j][3] * v[j][3]); s2 += (v2[j][0] * v2[j][0] + v2[j][1] * v2[j][1]) + (v2[j][2] * v2[j][2] + v2[j][3] * v2[j][3]); }
            s = wave_sum(s); s2 = wave_sum(s2);
            u32x2* o8 = (u32x2*)(XB + (size_t)row * 2048) + lane;
#pragma unroll
            for (int j = 0; j < 8; ++j) { u32x2 w; w.x = pk2(v[j][0], v[j][1]); w.y = pk2(v[j][2], v[j][3]); o8[64 * j] = w; }
            if (lane == 0) { R1[row] = rsqrtf(s * (1.f / 2048.f) + EPS); SS2[row] = 0.f; SS3[row] = 0.f; if (row < 64) { ((unsigned*)(ws + WS_CNT))[64 * row] = 0u; ((unsigned*)(ws + WS_CNT))[64 * 64 + 64 * row] = 0u; } }
            if (has2) {
                u32x2* o82 = (u32x2*)(XB + (size_t)row2 * 2048) + lane;
#pragma unroll
                for (int j = 0; j < 8; ++j) { u32x2 w; w.x = pk2(v2[j][0], v2[j][1]); w.y = pk2(v2[j][2], v2[j][3]); o82[64 * j] = w; }
                if (lane == 0) { R1[row2] = rsqrtf(s2 * (1.f / 2048.f) + EPS); SS2[row2] = 0.f; SS3[row2] = 0.f; }
            }
        }
    }
    SEAM(0);
    if (IN(1)) { F1 f{R1, RC, RS, Qb, Kb, Vb, Ub, nullptr}; gemm_run<F1>(lds, XB, WIN, S, INW, 2048, f, gw, NGW, lane); }
    SEAM(1);
    if (IN(2)) {
#if NAIVE_ATTN
        attn_naive(lds, Qb, Kb, Vb, CAT, gw, NGW, wave, lane);
#else
        attn_phase(lds, Qb, Kb, Vb, ws, PM, tid, wave, lane);
#endif
#if !NAIVE_S5
        for (int vb = blockIdx.x; vb < 256; vb += gridDim.x) s5_state_block(lds, WST, Ub, SC, vb, tid, wave, lane);
#endif
    }
    SEAM(2);
#if NAIVE_S5
    if (IN(3)) { if (gw < NG) s5_naive(lds, a, Ub, Yb, gw, wave, lane); }
    SEAM(3);
    SEAM(4);
#else
#ifndef MERGE_P34
#define MERGE_P34 1
#endif
#if MERGE_P34
    if (IN(3)) {
        unsigned* flg = (unsigned*)(ws + WS_CNT) + 64 * 64;
        const int G = (int)gridDim.x, b = (int)blockIdx.x;
        if (G == 256) {
            if (b < NG) {
                s5_scan_block(lds, a, SC, HP, b, wave, lane);
                asm volatile("s_waitcnt vmcnt(0)" ::: "memory");
                __syncthreads();
                if (tid == 0) { __builtin_amdgcn_fence(__ATOMIC_RELEASE, "agent"); asm volatile("s_waitcnt vmcnt(0)" ::: "memory"); __hip_atomic_store(flg + 64 * b, 1u, __ATOMIC_RELAXED, __HIP_MEMORY_SCOPE_AGENT); }
            }
            const long NIT = (long)S * 128, W = 192 * 5 + 64 * 3;
            const long c0 = b <= NG ? 3L * b : 192L + 5L * (b - NG), c1 = (b + 1) <= NG ? 3L * (b + 1) : 192L + 5L * (b + 1 - NG);
            const int i0 = (int)(NIT * c0 / W), i1 = (int)(NIT * c1 / W);
            attn_combine(ws, PM, CAT, i0 + tid, 512, i1);
            const int g = b >> 2;
            if (tid == 0) { unsigned sp = 0; while (__hip_atomic_load(flg + 64 * g, __ATOMIC_RELAXED, __HIP_MEMORY_SCOPE_AGENT) == 0u) { __builtin_amdgcn_s_sleep(4); if (++sp > (1u << 22)) break; }
                __builtin_amdgcn_fence(__ATOMIC_ACQUIRE, "agent"); asm volatile("s_waitcnt vmcnt(0)" ::: "memory"); }
            __syncthreads();
            s5_out_block2(lds, MLAG, WC, HP, Ub, a.in[10], Yb, b, tid, wave, lane);
        } else {
            for (int g = blockIdx.x; g < NG; g += gridDim.x) s5_scan_block(lds, a, SC, HP, g, wave, lane);
            attn_combine(ws, PM, CAT, blockIdx.x * 512 + tid, gridDim.x * 512);
            xcd_barrier(xb);
            for (int vb = blockIdx.x; vb < 256; vb += gridDim.x) s5_out_block2(lds, MLAG, WC, HP, Ub, a.in[10], Yb, vb, tid, wave, lane);
        }
    }
    if (IN(3) && !IN(4)) { }
    if (IN(4) && IN(5)) xcd_barrier(xb);
#else
    if (IN(3)) {
        for (int g = blockIdx.x; g < NG; g += gridDim.x) s5_scan_block(lds, a, SC, HP, g, wave, lane);
#if !NAIVE_ATTN
        attn_combine(ws, PM, CAT, blockIdx.x * 512 + tid, gridDim.x * 512);
#endif
    }
    SEAM(3);
    if (IN(4)) { for (int vb = blockIdx.x; vb < 256; vb += gridDim.x) s5_out_block2(lds, MLAG, WC, HP, Ub, a.in[10], Yb, vb, tid, wave, lane); }
    SEAM(4);
#endif
#endif
    if (IN(5)) { F2 f{Yb, a.in[12], CAT, nullptr}; gemm_run<F2>(lds, Yb, WGLU, S, 1024, 1024, f, gw, NGW, lane); }
    SEAM(5);
    if (IN(6)) { F3 f{a.in[0], a.out, XB, SS2}; gemm_run<F3>(lds, CAT, WOUT, S, 2048, 2048, f, gw, NGW, lane); }
    SEAM(6);
#if USE_PG8
    if (IN(7)) { pg8::Gemm g{XB, WGU, S, 2 * DFF, 2048}; pg8::StaticOrder So; So.init(S, 2 * DFF, (int)gridDim.x, (int)blockIdx.x); EpiSwiGLU E{SS2, HH};
        pg8::gemm_phase<EpiSwiGLU, pg8::StaticOrder, true, true>(lds, g, So, E); }
#else
    if (IN(7)) { F4 f{SS2, HH, nullptr}; gemm_run<F4>(lds, XB, WGU, S, 2 * DFF, 2048, f, gw, NGW, lane); }
#endif
    SEAM(7);
#if FUSE_NORM && USE_PG8
    if (IN(8)) {
        pg8::Gemm g{HH, WDN, S, 2048, DFF}; PanelOrder So; So.init(S, 2048, (int)gridDim.x, (int)blockIdx.x);
        EpiDownNorm E{a.out, XB, a.out, SS3, (unsigned*)(ws + WS_CNT), a.in[18]};
        pg8::gemm_phase<EpiDownNorm, PanelOrder, true, true>(lds, g, So, E);
    }
#else
    if (IN(8)) { F5 f{a.out, SS3}; gemm_run<F5>(lds, HH, WDN, S, 2048, DFF, f, gw, NGW, lane); }
#endif
    SEAM(8);
    if (IN(9)) {
        const float* fg = a.in[18];
        for (int row = gw; row < S; row += NGW) {
            const float r = rsqrtf(SS3[row] * (1.f / 2048.f) + EPS);
            f32x4* orow = (f32x4*)(a.out + (size_t)row * 2048) + lane;
#pragma unroll
            for (int j = 0; j < 8; ++j) { const f32x4 g = ((const f32x4*)fg)[64 * j + lane]; f32x4 v = orow[64 * j]; v = v * r * g; orow[64 * j] = v; }
        }
    }
#ifdef PROBE_CUTS
    if (IN(10)) { F0 f{SS3 + 20000, nullptr}; gemm_run<F0>(lds, XB, WGU, S, 2 * DFF, 2048, f, gw, NGW, lane); }
#endif
#undef IN
#undef SEAM
}

extern "C" void kernel_launch(void* const* d_in, const int* in_sizes, int n_in, void* d_out, int out_size, void* d_ws, size_t ws_size, hipStream_t stream) {
    static int grid = 0;
    if (grid == 0) {
        if (n_in != 19 || ws_size < WS_END3) { fprintf(stderr, "kernel_launch: unexpected n_in %d / ws %zu\n", n_in, ws_size); grid = -1; return; }
        int dev = 0, cus = 0, per_cu = 0;
        (void)hipGetDevice(&dev);
        (void)hipDeviceGetAttribute(&cus, hipDeviceAttributeMultiprocessorCount, dev);
        (void)hipFuncSetAttribute((const void*)mega, hipFuncAttributeMaxDynamicSharedMemorySize, LDS_BYTES);
        (void)hipOccupancyMaxActiveBlocksPerMultiprocessor(&per_cu, (const void*)mega, 512, LDS_BYTES);
        if (per_cu < 1) per_cu = 1;
        grid = cus * per_cu;
        (void)hipGetLastError();
    }
    if (grid < 0) return;
    Args a{};
    for (int i = 0; i < 19; ++i) a.in[i] = (const float*)d_in[i];
    a.out = (float*)d_out; a.ws = (unsigned char*)d_ws;
#if N_LAUNCH_MODE == 1
    for (int ph = 0; ph < NPHASE; ++ph) {
        if (ph == 4 && NAIVE_S5) continue;
        a.ph_lo = ph; a.ph_hi = ph + 1;
        hipLaunchKernelGGL(mega, dim3(grid), dim3(512), LDS_BYTES, stream, a);
    }
#else
#ifdef PROBE_CUTS
    const int cuts[][2] = PROBE_CUTS;
    const int nl = (int)(sizeof(cuts) / sizeof(cuts[0]));
#elif defined(PROBE_SPLIT)
    const int cuts[2][2] = {{0, PROBE_SPLIT + 1}, {PROBE_SPLIT + PROBE_DUP - 1, NPHASE}};
    const int nl = 2;
#else
    const int cuts[1][2] = {{0, NPHASE}};
    const int nl = 1;
#endif
    for (int li = 0; li < nl; ++li) {
        (void)hipMemsetAsync((unsigned char*)d_ws + WS_BAR, 0, XCD_BAR_WORDS * 4, stream);
        a.ph_lo = cuts[li][0]; a.ph_hi = cuts[li][1];
        void* args[] = {&a};
        hipError_t e = hipLaunchCooperativeKernel((const void*)mega, dim3(grid), dim3(512), args, LDS_BYTES, stream);
        if (e != hipSuccess) fprintf(stderr, "cooperative launch failed: %s (grid %d)\n", hipGetErrorString(e), grid);
    }
#endif
}
```
